# Optimizing an MI355X kernel written in HIP

```python
import jax, jax.numpy as jnp
from jax import lax
import numpy as np

D_MODEL = 2048
BATCH = 4
SEQ = 2048
DEPTH = 4

D_MIX = D_MODEL
N_MIXERS = 4
W_BR = D_MIX // N_MIXERS
HEAD_DIM = 128
N_HEADS_BR = W_BR // HEAD_DIM
GLA_DK = W_BR // 2
GLA_HEAD_K = GLA_DK // N_HEADS_BR
GLA_LOWRANK = 16
GLA_TAU = 16.0
GLA_CHUNK = 64
LRU_C = 8.0
LRU_CONV = 4
NSA_DH = HEAD_DIM
CMP_LEN = 32
CMP_STRIDE = 16
CMP_HIDDEN = 128
SLC_LEN = 64
SLC_TOPN = 16
SLC_Q_BLOCK = 64
WIN = 512
Q_BLOCK = 128
WIN_BLOCKS = WIN // Q_BLOCK
FORCED_SCORE = 1e3
CONF_KERNEL = 31
EPS = 1e-6

PROJ_SIZES = (
    GLA_DK, GLA_DK, W_BR, GLA_LOWRANK, W_BR,
    W_BR, W_BR,
    W_BR, NSA_DH, NSA_DH, NSA_DH, NSA_DH, NSA_DH, NSA_DH,
    3 * N_HEADS_BR, W_BR,
    W_BR, W_BR, W_BR,
)
D_PROJ = sum(PROJ_SIZES)

kernel_name = 'hybrid_gla_rglru_nsa_conformer_trunk'

F32 = jnp.float32


def rmsnorm(x, g):
    x32 = x.astype(F32)
    y = x32 * lax.rsqrt(jnp.mean(x32 * x32, axis=-1, keepdims=True) + EPS)
    return (y * g.astype(F32)).astype(x.dtype)


def group_rmsnorm(y, g):
    shp = y.shape
    y32 = y.astype(F32).reshape(shp[:-1] + (shp[-1] // HEAD_DIM, HEAD_DIM))
    y32 = y32 * lax.rsqrt(jnp.mean(y32 * y32, axis=-1, keepdims=True) + EPS)
    return (y32.reshape(shp) * g.astype(F32)).astype(y.dtype)


def layernorm(x, g, b):
    x32 = x.astype(F32)
    mu = jnp.mean(x32, axis=-1, keepdims=True)
    xc = x32 - mu
    var = jnp.mean(xc * xc, axis=-1, keepdims=True)
    return (xc * lax.rsqrt(var + EPS) * g.astype(F32) + b.astype(F32)).astype(x.dtype)


def causal_dwconv(x, w, b):
    width, ch = w.shape
    y = lax.conv_general_dilated(x, w[:, None, :].astype(x.dtype), window_strides=(1,),
                                 padding=((width - 1, 0),),
                                 dimension_numbers=('NWC', 'WIO', 'NWC'),
                                 feature_group_count=ch)
    return y + b.astype(x.dtype)


def masked_softmax(s, mask):
    s = jnp.where(mask, s.astype(F32), -jnp.inf)
    m = jnp.max(s, axis=-1, keepdims=True)
    m = jnp.where(jnp.isfinite(m), m, 0.0)
    p = jnp.exp(s - m)
    return p / jnp.maximum(jnp.sum(p, axis=-1, keepdims=True), 1e-30)


def gla_mixer(q, k, v, fg, w_fg2, b_fg2):
    B, S, _ = q.shape
    H, C = N_HEADS_BR, GLA_CHUNK
    N = S // C

    def chunks(t, d):
        return t.reshape(B, N, C, H, d).transpose(0, 3, 1, 2, 4)

    log_f = jax.nn.log_sigmoid((fg @ w_fg2 + b_fg2).astype(F32)) / GLA_TAU
    qc = chunks(q.astype(F32) * GLA_HEAD_K ** -0.5, GLA_HEAD_K)
    kc = chunks(k.astype(F32), GLA_HEAD_K)
    vc = chunks(v.astype(F32), HEAD_DIM)
    bcum = jnp.cumsum(chunks(log_f, GLA_HEAD_K), axis=3)
    b_last = bcum[:, :, :, -1:, :]
    q_dec = qc * jnp.exp(bcum)
    causal = jnp.tril(jnp.ones((C, C), dtype=bool))
    attn = jnp.where(causal, jnp.einsum('bhncd,bhnjd->bhncj', q_dec, kc * jnp.exp(-bcum)), 0.0)
    o_intra = jnp.einsum('bhncj,bhnje->bhnce', attn, vc)
    dstate = jnp.einsum('bhncd,bhnce->bhnde', kc * jnp.exp(b_last - bcum), vc)
    decay = jnp.exp(b_last[:, :, :, 0, :])

    def step(state, inp):
        dec, ds = inp
        return dec[..., None] * state + ds, state

    _, s_prev = lax.scan(step, jnp.zeros((B, H, GLA_HEAD_K, HEAD_DIM), F32),
                         (jnp.moveaxis(decay, 2, 0), jnp.moveaxis(dstate, 2, 0)))
    s_prev = jnp.moveaxis(s_prev, 0, 2)
    o = o_intra + jnp.einsum('bhncd,bhnde->bhnce', q_dec, s_prev)
    return o.transpose(0, 2, 3, 1, 4).reshape(B, S, H * HEAD_DIM)


def rglru_mixer(xb, conv_w, conv_b, w_a, b_a, w_x, b_x, lam):
    B, S, W = xb.shape
    xc = causal_dwconv(xb, conv_w, conv_b)
    xh = xc.reshape(B, S, N_HEADS_BR, HEAD_DIM)
    r = jax.nn.sigmoid((jnp.einsum('bshi,hij->bshj', xh, w_a).reshape(B, S, W) + b_a).astype(F32))
    ig = jax.nn.sigmoid((jnp.einsum('bshi,hij->bshj', xh, w_x).reshape(B, S, W) + b_x).astype(F32))
    log_a = -LRU_C * r * jax.nn.softplus(-lam.astype(F32))
    a = jnp.exp(log_a)
    u = jnp.sqrt(-jnp.expm1(2.0 * log_a)) * (ig * xc.astype(F32))

    def combine(left, right):
        a1, b1 = left
        a2, b2 = right
        return a1 * a2, a2 * b1 + b2

    _, h = lax.associative_scan(combine, (a, u), axis=1)
    return h


def nsa_mixer(q, kc, vc, ks, vs, kw, vw, gates, pos_k, w1_k, w2_k, pos_v, w1_v, w2_v):
    B, S, _ = q.shape
    H, Dh = N_HEADS_BR, NSA_DH
    scale = Dh ** -0.5
    qh = q.reshape(B, S, H, Dh)
    t = jnp.arange(S)

    n_cmp = (S - CMP_LEN) // CMP_STRIDE + 1
    cstart = jnp.arange(n_cmp) * CMP_STRIDE
    blk = cstart[:, None] + jnp.arange(CMP_LEN)[None]

    def compress(z, pos, w1, w2):
        zb = (z[:, blk] + pos).reshape(B, n_cmp, CMP_LEN * Dh)
        return jax.nn.silu(zb @ w1) @ w2

    k_cmp = compress(kc, pos_k, w1_k, w2_k)
    v_cmp = compress(vc, pos_v, w1_v, w2_v)
    cmp_mask = (t[:, None] >= (cstart + CMP_LEN - 1)[None])[None, None]
    p_cmp = masked_softmax(jnp.einsum('bshd,bnd->bhsn', qh, k_cmp) * scale, cmp_mask)
    o_cmp = jnp.einsum('bhsn,bnd->bshd', p_cmp, v_cmp)

    n_sel = S // SLC_LEN
    j = jnp.arange(n_sel)
    overlap = ((cstart[:, None] < (j[None] + 1) * SLC_LEN) &
               (cstart[:, None] + CMP_LEN > j[None] * SLC_LEN)).astype(F32)
    imp = jnp.einsum('bhsn,nj->bsj', p_cmp, overlap)
    cur = (t // SLC_LEN)[:, None]
    forced = (j[None] == 0) | (j[None] == cur) | (j[None] == cur - 1)
    imp = jnp.where(j[None] > cur, -jnp.inf, jnp.where(forced, FORCED_SCORE, imp))
    n_top = min(SLC_TOPN, n_sel)
    _, sel = lax.top_k(imp, n_top)

    ks_blk = ks.reshape(B, n_sel, SLC_LEN, Dh)
    vs_blk = vs.reshape(B, n_sel, SLC_LEN, Dh)
    nq = S // SLC_Q_BLOCK

    def sel_block(args):
        q_b, sel_b, t_b = args
        kg = jax.vmap(lambda kb, ib: kb[ib])(ks_blk, sel_b)
        vg = jax.vmap(lambda vb, ib: vb[ib])(vs_blk, sel_b)
        kpos = sel_b[..., None] * SLC_LEN + jnp.arange(SLC_LEN)
        mask = (kpos <= t_b[None, :, None, None]).reshape(B, SLC_Q_BLOCK, 1, n_top * SLC_LEN)
        s = jnp.einsum('bqhd,bqkld->bqhkl', q_b, kg).reshape(B, SLC_Q_BLOCK, H, n_top * SLC_LEN) * scale
        p = masked_softmax(s, mask).reshape(B, SLC_Q_BLOCK, H, n_top, SLC_LEN)
        return jnp.einsum('bqhkl,bqkld->bqhd', p, vg)

    o_slc = lax.map(sel_block, (qh.reshape(B, nq, SLC_Q_BLOCK, H, Dh).swapaxes(0, 1),
                                sel.reshape(B, nq, SLC_Q_BLOCK, n_top).swapaxes(0, 1),
                                t.reshape(nq, SLC_Q_BLOCK)))
    o_slc = o_slc.swapaxes(0, 1).reshape(B, S, H, Dh)

    nb = S // Q_BLOCK
    pad = WIN_BLOCKS * Q_BLOCK

    def band(z):
        zb = jnp.pad(z, ((0, 0), (pad, 0), (0, 0))).reshape(B, nb + WIN_BLOCKS, Q_BLOCK, Dh)
        return jnp.concatenate([zb[:, i:i + nb] for i in range(WIN_BLOCKS + 1)], axis=2)

    kwin, vwin = band(kw), band(vw)
    qpos = t.reshape(nb, Q_BLOCK)
    kpos = (jnp.arange(nb)[:, None] - WIN_BLOCKS) * Q_BLOCK + jnp.arange((WIN_BLOCKS + 1) * Q_BLOCK)[None]
    dist = qpos[:, :, None] - kpos[:, None, :]
    wmask = (dist >= 0) & (dist < WIN) & (kpos[:, None, :] >= 0)
    s = jnp.einsum('bnqhd,bnkd->bnhqk', qh.reshape(B, nb, Q_BLOCK, H, Dh), kwin) * scale
    p = masked_softmax(s, wmask[None, :, None])
    o_win = jnp.einsum('bnhqk,bnkd->bnqhd', p, vwin).reshape(B, S, H, Dh)

    g = jax.nn.sigmoid(gates.astype(F32)).reshape(B, S, H, 3)
    o = g[..., 0:1] * o_cmp + g[..., 1:2] * o_slc + g[..., 2:3] * o_win
    return o.reshape(B, S, H * Dh)


def conformer_mixer(val, glu, dw_w, dw_b, ln_g, ln_b, pw_w, pw_b):
    y = val * jax.nn.sigmoid(glu)
    y = causal_dwconv(y, dw_w, dw_b)
    y = layernorm(y, ln_g, ln_b)
    return jax.nn.silu(y) @ pw_w + pw_b


def hybrid_layer(x, pre_g, w_in, gla_w_fg2, gla_b_fg2, lru_conv_w, lru_conv_b, lru_w_a, lru_b_a,
                 lru_w_x, lru_b_x, lru_lambda, cmp_pos_k, cmp_w1_k, cmp_w2_k, cmp_pos_v, cmp_w1_v,
                 cmp_w2_v, conf_dw_w, conf_dw_b, conf_ln_g, conf_ln_b, conf_pw_w, conf_pw_b,
                 branch_g, w_out, post_g):
    dt = x.dtype
    h = rmsnorm(x, pre_g)
    proj = h @ w_in
    (gla_q, gla_k, gla_v, gla_fg, gla_z, lru_x, lru_z, nsa_q, nsa_kc, nsa_vc, nsa_ks, nsa_vs,
     nsa_kw, nsa_vw, nsa_g, nsa_z, conv_v, conv_glu, conv_z) = jnp.split(
        proj, np.cumsum(PROJ_SIZES)[:-1].tolist(), axis=-1)
    o_a = gla_mixer(gla_q, gla_k, gla_v, gla_fg, gla_w_fg2, gla_b_fg2)
    o_b = rglru_mixer(lru_x, lru_conv_w, lru_conv_b, lru_w_a, lru_b_a, lru_w_x, lru_b_x, lru_lambda)
    o_c = nsa_mixer(nsa_q, nsa_kc, nsa_vc, nsa_ks, nsa_vs, nsa_kw, nsa_vw, nsa_g,
                    cmp_pos_k, cmp_w1_k, cmp_w2_k, cmp_pos_v, cmp_w1_v, cmp_w2_v)
    o_d = conformer_mixer(conv_v, conv_glu, conf_dw_w, conf_dw_b, conf_ln_g, conf_ln_b, conf_pw_w, conf_pw_b)
    mixed = jnp.concatenate([o_a.astype(dt), o_b.astype(dt), o_c.astype(dt), o_d.astype(dt)], axis=-1)
    gate = jax.nn.silu(jnp.concatenate([gla_z, lru_z, nsa_z, conv_z], axis=-1))
    mixed = (group_rmsnorm(mixed, branch_g) * gate).astype(dt)
    y = mixed @ w_out
    return x + rmsnorm(y, post_g)


def setup_inputs(seed: int = 0) -> dict:
    key = jax.random.key(seed)
    keys = iter(jax.random.split(key, 32))
    L = DEPTH

    def nrm(shape, s):
        return jax.random.normal(next(keys), shape, F32) * s

    def gain(shape):
        return 1.0 + nrm(shape, 0.02)

    x = nrm((BATCH, SEQ, D_MODEL), 1.0)
    pre_norm_g = gain((L, D_MODEL))
    w_in = nrm((L, D_MODEL, D_PROJ), D_MODEL ** -0.5)
    gla_w_fg2 = nrm((L, GLA_LOWRANK, GLA_DK), GLA_LOWRANK ** -0.5)
    gla_b_fg2 = nrm((L, GLA_DK), 0.01)
    lru_conv_w = nrm((L, LRU_CONV, W_BR), LRU_CONV ** -0.5)
    lru_conv_b = nrm((L, W_BR), 0.01)
    lru_w_a = nrm((L, N_HEADS_BR, HEAD_DIM, HEAD_DIM), HEAD_DIM ** -0.5)
    lru_b_a = nrm((L, W_BR), 0.01)
    lru_w_x = nrm((L, N_HEADS_BR, HEAD_DIM, HEAD_DIM), HEAD_DIM ** -0.5)
    lru_b_x = nrm((L, W_BR), 0.01)
    u = jax.random.uniform(next(keys), (L, W_BR), F32, 0.9, 0.999)
    a0 = u ** (1.0 / LRU_C)
    lru_lambda = jnp.log(a0) - jnp.log1p(-a0)
    nsa_cmp_pos_k = nrm((L, CMP_LEN, NSA_DH), 0.02)
    nsa_cmp_w1_k = nrm((L, CMP_LEN * NSA_DH, CMP_HIDDEN), (CMP_LEN * NSA_DH) ** -0.5)
    nsa_cmp_w2_k = nrm((L, CMP_HIDDEN, NSA_DH), CMP_HIDDEN ** -0.5)
    nsa_cmp_pos_v = nrm((L, CMP_LEN, NSA_DH), 0.02)
    nsa_cmp_w1_v = nrm((L, CMP_LEN * NSA_DH, CMP_HIDDEN), (CMP_LEN * NSA_DH) ** -0.5)
    nsa_cmp_w2_v = nrm((L, CMP_HIDDEN, NSA_DH), CMP_HIDDEN ** -0.5)
    conf_dw_w = nrm((L, CONF_KERNEL, W_BR), CONF_KERNEL ** -0.5)
    conf_dw_b = nrm((L, W_BR), 0.01)
    conf_ln_g = gain((L, W_BR))
    conf_ln_b = nrm((L, W_BR), 0.01)
    conf_pw_w = nrm((L, W_BR, W_BR), W_BR ** -0.5)
    conf_pw_b = nrm((L, W_BR), 0.01)
    branch_norm_g = gain((L, D_MIX))
    w_out = nrm((L, D_MIX, D_MODEL), D_MIX ** -0.5)
    post_norm_g = gain((L, D_MODEL))
    return {'x': x, 'pre_norm_g': pre_norm_g, 'w_in': w_in, 'gla_w_fg2': gla_w_fg2,
            'gla_b_fg2': gla_b_fg2, 'lru_conv_w': lru_conv_w, 'lru_conv_b': lru_conv_b,
            'lru_w_a': lru_w_a, 'lru_b_a': lru_b_a, 'lru_w_x': lru_w_x, 'lru_b_x': lru_b_x,
            'lru_lambda': lru_lambda, 'nsa_cmp_pos_k': nsa_cmp_pos_k, 'nsa_cmp_w1_k': nsa_cmp_w1_k,
            'nsa_cmp_w2_k': nsa_cmp_w2_k, 'nsa_cmp_pos_v': nsa_cmp_pos_v, 'nsa_cmp_w1_v': nsa_cmp_w1_v,
            'nsa_cmp_w2_v': nsa_cmp_w2_v, 'conf_dw_w': conf_dw_w, 'conf_dw_b': conf_dw_b,
            'conf_ln_g': conf_ln_g, 'conf_ln_b': conf_ln_b, 'conf_pw_w': conf_pw_w,
            'conf_pw_b': conf_pw_b, 'branch_norm_g': branch_norm_g, 'w_out': w_out,
            'post_norm_g': post_norm_g}


def reference(x, pre_norm_g, w_in, gla_w_fg2, gla_b_fg2, lru_conv_w, lru_conv_b, lru_w_a, lru_b_a,
              lru_w_x, lru_b_x, lru_lambda, nsa_cmp_pos_k, nsa_cmp_w1_k, nsa_cmp_w2_k, nsa_cmp_pos_v,
              nsa_cmp_w1_v, nsa_cmp_w2_v, conf_dw_w, conf_dw_b, conf_ln_g, conf_ln_b, conf_pw_w,
              conf_pw_b, branch_norm_g, w_out, post_norm_g):
    for l in range(DEPTH):
        x = hybrid_layer(x, pre_norm_g[l], w_in[l], gla_w_fg2[l], gla_b_fg2[l], lru_conv_w[l],
                         lru_conv_b[l], lru_w_a[l], lru_b_a[l], lru_w_x[l], lru_b_x[l], lru_lambda[l],
                         nsa_cmp_pos_k[l], nsa_cmp_w1_k[l], nsa_cmp_w2_k[l], nsa_cmp_pos_v[l],
                         nsa_cmp_w1_v[l], nsa_cmp_w2_v[l], conf_dw_w[l], conf_dw_b[l], conf_ln_g[l],
                         conf_ln_b[l], conf_pw_w[l], conf_pw_b[l], branch_norm_g[l], w_out[l],
                         post_norm_g[l])
    return x
```

```cpp
#ifdef CPU_EMU
#include "hipemu.h"
#else
#include <hip/hip_runtime.h>
#include <hip/hip_cooperative_groups.h>
#include <cstdio>
#include <cstdint>
typedef short bf16x8 __attribute__((ext_vector_type(8)));
typedef short s16x4 __attribute__((ext_vector_type(4)));
typedef float f32x16 __attribute__((ext_vector_type(16)));
typedef float f32x4 __attribute__((ext_vector_type(4)));
typedef float f32x2 __attribute__((ext_vector_type(2)));
typedef unsigned u32x4 __attribute__((ext_vector_type(4)));
typedef unsigned u32x2 __attribute__((ext_vector_type(2)));
#endif
#include <cmath>

#ifndef PROBE_K
#define PROBE_K 0
#endif
#ifndef PROBE_U
#define PROBE_U 0
#endif
#ifndef PROBE_C
#define PROBE_C 0
#endif
#ifndef BATCH
#define BATCH 4
#endif
#ifndef DEPTH
#define DEPTH 4
#endif
#define DEV __device__ __forceinline__
typedef unsigned short bf16_t;

#ifdef CPU_EMU
#define MFMA32(a, b, c) emu_mfma32(a, b, c)
#define MFMA16(a, b, c) emu_mfma16(a, b, c)
#define SHFLX(v, m) emu_shfl_xor(v, m)
#define SHFLXU(v, m) emu_shfl_xor_u(v, m)
#define SHFL(v, s) emu_shfl(v, s)
#define PLSWAP(a, b) emu_permlane32_swap(a, b)
#define ANY(p) emu_any(p)
#define ALL(p) emu_all(p)
#define EXP2F(x) exp2f(x)
#define EXPF(x) expf(x)
#define LOGF(x) logf(x)
#define RCPF(x) (1.0f / (x))
#define RSQF(x) (1.0f / sqrtf(x))
#define LDS_ADDR(p) ((unsigned)((const unsigned char*)(p) - emu::lds_mem))
#define TRREAD(dst, base, off) dst = emu_ds_read_tr16((unsigned)((base) + (off)))
#define WAVE_SYNC() (void)emu_any(false)
#define LGKM0()
#define SBAR()
#define UNIFORM(x) (x)
#define LAUNDER(p)
#define GLDS16(src, ldsdst) memcpy((unsigned char*)(ldsdst) + (threadIdx.x & 63) * 16, (const void*)(src), 16)
#define DMA_WAIT()
static inline unsigned cvtpk(float lo, float hi) { return (unsigned)emu::f2bf(lo) | ((unsigned)emu::f2bf(hi) << 16); }
#else
#define MFMA32(a, b, c) __builtin_amdgcn_mfma_f32_32x32x16_bf16(a, b, c, 0, 0, 0)
#define MFMA16(a, b, c) __builtin_amdgcn_mfma_f32_16x16x32_bf16(a, b, c, 0, 0, 0)
#define SHFLX(v, m) __shfl_xor(v, m)
#define SHFLXU(v, m) ((unsigned)__shfl_xor((int)(v), m))
#define SHFL(v, s) __shfl(v, s)
#define PLSWAP(a, b) __builtin_amdgcn_permlane32_swap(a, b, false, false)
#define ANY(p) __any(p)
#define ALL(p) __all(p)
#define EXP2F(x) __builtin_amdgcn_exp2f(x)
#define EXPF(x) __expf(x)
#define LOGF(x) __logf(x)
#define RCPF(x) __builtin_amdgcn_rcpf(x)
#define RSQF(x) __builtin_amdgcn_rsqf(x)
#define LDS_ADDR(p) ((unsigned)(uintptr_t)(p))
#define TRREAD(dst, base, off) asm volatile("ds_read_b64_tr_b16 %0, %1 offset:%2" : "=&v"(dst) : "v"(base), "i"(off) : "memory")
#define WAVE_SYNC() asm volatile("s_waitcnt lgkmcnt(0)" ::: "memory")
#define LGKM0() asm volatile("s_waitcnt lgkmcnt(0)" ::: "memory")
#define SBAR() __builtin_amdgcn_sched_barrier(0)
#define UNIFORM(x) __builtin_amdgcn_readfirstlane(x)
#define LAUNDER(p) asm volatile("" : "+v"(p))
#define GLDS16(src, ldsdst) __builtin_amdgcn_global_load_lds((const unsigned*)(src), (__attribute__((address_space(3))) unsigned*)(ldsdst), 16, 0, 0)
#define DMA_WAIT() asm volatile("s_waitcnt vmcnt(0)" ::: "memory")
DEV unsigned cvtpk(float lo, float hi) { unsigned r; asm volatile("v_cvt_pk_bf16_f32 %0, %1, %2" : "=v"(r) : "v"(lo), "v"(hi)); return r; }
#endif

#ifdef CPU_EMU
static inline int opaque_tid() { return (int)threadIdx.x; }
#else
DEV int opaque_tid() { int t = threadIdx.x; asm volatile("" : "+v"(t)); return t; }
#endif
DEV unsigned f_as_u(float f) { return __builtin_bit_cast(unsigned, f); }
DEV float u_as_f(unsigned u) { return __builtin_bit_cast(float, u); }
DEV bf16_t f2bf(float f) { unsigned u = f_as_u(f); return (bf16_t)((u + 0x7fffu + ((u >> 16) & 1u)) >> 16); }
DEV float bf2f(bf16_t h) { return u_as_f((unsigned)h << 16); }
DEV unsigned pk2(float lo, float hi) { return (unsigned)f2bf(lo) | ((unsigned)f2bf(hi) << 16); }
DEV float wave_sum(float v) {
#pragma unroll
    for (int o = 1; o < 64; o <<= 1) v += SHFLX(v, o);
    return v;
}
DEV float sigm(float x) { return RCPF(1.0f + EXPF(-x)); }
DEV float siluf(float x) { return x * sigm(x); }
DEV bf16x8 pack8(f32x4 a, f32x4 b) { u32x4 w = {cvtpk(a[0], a[1]), cvtpk(a[2], a[3]), cvtpk(b[0], b[1]), cvtpk(b[2], b[3])}; return __builtin_bit_cast(bf16x8, w); }

constexpr int SEQ = 2048, T = BATCH * SEQ, DM = 2048, NP = 6144, DPROJ = 5916, NTHR = 512;
constexpr float EPS = 1e-6f;
constexpr int C_GQ = 0, C_GK = 256, C_GV = 512, C_GZ = 1024, C_LX = 1536, C_LZ = 2048, C_NQ = 2560, C_KC = 3072, C_VC = 3200, C_KS = 3328,
              C_VS = 3456, C_KW = 3584, C_VW = 3712, C_NZ = 3840, C_CV = 4352, C_CG = 4864, C_CZ = 5376, C_FG = 5888, C_NG = 5904;
__host__ __device__ inline int win_src_col(int n) {
    if (n < 1024) return n;
    if (n < 3840) return n + 16;
    if (n < 5888) return n + 28;
    if (n < 5904) return n - 5888 + 1024;
    if (n < 5916) return n - 5904 + 3856;
    return -1;
}
enum { I_X = 0, I_PRE_G, I_W_IN, I_FG2_W, I_FG2_B, I_LCONV_W, I_LCONV_B, I_LWA, I_LBA, I_LWX, I_LBX, I_LLAM, I_POSK, I_W1K, I_W2K, I_POSV, I_W1V, I_W2V,
       I_DW_W, I_DW_B, I_LN_G, I_LN_B, I_PW_W, I_PW_B, I_BR_G, I_W_OUT, I_POST_G, N_IN };
constexpr size_t MiB = 1u << 20;
constexpr size_t al(size_t x) { return (x + MiB - 1) / MiB * MiB; }
constexpr size_t WS_CTL = 0;
constexpr size_t WS_PAR = 65536;
constexpr size_t WS_WIN = 1 * MiB;
constexpr size_t WS_WOUT = WS_WIN + al((size_t)DEPTH * NP * DM * 2);
constexpr size_t WS_PW = WS_WOUT + al((size_t)DEPTH * DM * DM * 2);
constexpr size_t WS_W1 = WS_PW + al((size_t)DEPTH * 512 * 512 * 2);
constexpr size_t WS_W2 = WS_W1 + al((size_t)DEPTH * 2 * 128 * 4096 * 2);
constexpr size_t WS_LRU = WS_W2 + al((size_t)DEPTH * 2 * 128 * 128 * 2);
constexpr size_t WS_H = WS_LRU + al((size_t)DEPTH * 8 * 128 * 128 * 2);
constexpr size_t WS_PROJ = WS_H + al((size_t)T * DM * 2);
constexpr size_t WS_MIXED = WS_PROJ + al((size_t)T * NP * 2);
constexpr size_t WS_Y = WS_MIXED + al((size_t)T * DM * 2);
constexpr size_t WS_KCMP = WS_Y + al((size_t)T * DM * 2);
constexpr size_t WS_GOI = WS_KCMP + al((size_t)2 * BATCH * 128 * 128 * 2);
constexpr size_t WS_GDS = WS_GOI + al((size_t)BATCH * 128 * 64 * 128 * 4);
constexpr size_t WS_GQD = WS_GDS + al((size_t)BATCH * 128 * 64 * 128 * 4);
constexpr size_t WS_GDEC = WS_GQD + al((size_t)BATCH * 128 * 64 * 64 * 2);
constexpr size_t WS_GST = WS_GDEC + al((size_t)BATCH * 128 * 64 * 4);
constexpr size_t WS_LH = WS_GST + al((size_t)BATCH * 128 * 8192 * 2);
constexpr size_t WS_LP = WS_LH + al((size_t)T * 512 * 4);
constexpr size_t WS_LCAR = WS_LP + al((size_t)T * 512 * 4);
constexpr size_t WS_NACC = WS_LCAR + al((size_t)BATCH * 32 * 512 * 4);
constexpr size_t WS_NSLC = WS_NACC + al((size_t)BATCH * 96 * 256 * 128 * 4);
constexpr size_t WS_NML = WS_NSLC + al((size_t)BATCH * 96 * 256 * 128 * 4);
constexpr size_t WS_XA = WS_NML + al((size_t)BATCH * 96 * 256 * 2 * 4);
constexpr size_t WS_XB = WS_XA + al((size_t)T * DM * 4);
constexpr size_t WS_KVC = WS_XB + al((size_t)T * DM * 4);
constexpr size_t WS_CPART = WS_KVC + al((size_t)3 * T * 256 * 2);
constexpr size_t WS_XSL = WS_CPART + al((size_t)2 * BATCH * 9 * 4 * 2048 * 4);
constexpr size_t WS_END = WS_XSL + al((size_t)(DEPTH * 2 + 1) * T * 8 * 4);
constexpr size_t WS_XCNT = 819200;
constexpr size_t WS_CCNT = 57344;
constexpr size_t WS_NCNT = 53248;
constexpr int LDS_BYTES = 144 * 1024;

struct ParSeg { int idx, per_layer, off; };
constexpr int PO_PRE_G = 0, PO_FG2_W = PO_PRE_G + DEPTH * 2048, PO_FG2_B = PO_FG2_W + DEPTH * 4096, PO_LCONV_W = PO_FG2_B + DEPTH * 256, PO_LCONV_B = PO_LCONV_W + DEPTH * 2048,
              PO_LBA = PO_LCONV_B + DEPTH * 512, PO_LBX = PO_LBA + DEPTH * 512, PO_LLAM = PO_LBX + DEPTH * 512, PO_POSK = PO_LLAM + DEPTH * 512, PO_POSV = PO_POSK + DEPTH * 4096,
              PO_DW_W = PO_POSV + DEPTH * 4096, PO_DW_B = PO_DW_W + DEPTH * 31 * 512, PO_LN_G = PO_DW_B + DEPTH * 512, PO_LN_B = PO_LN_G + DEPTH * 512, PO_PW_B = PO_LN_B + DEPTH * 512,
              PO_BR_G = PO_PW_B + DEPTH * 512, PO_POST_G = PO_BR_G + DEPTH * 2048, PO_END = PO_POST_G + DEPTH * 2048;
constexpr int N_PARSEG = 17;
__device__ const ParSeg PARSEG[N_PARSEG] = {{I_PRE_G, 2048, PO_PRE_G}, {I_FG2_W, 4096, PO_FG2_W}, {I_FG2_B, 256, PO_FG2_B}, {I_LCONV_W, 2048, PO_LCONV_W}, {I_LCONV_B, 512, PO_LCONV_B},
    {I_LBA, 512, PO_LBA}, {I_LBX, 512, PO_LBX}, {I_LLAM, 512, PO_LLAM}, {I_POSK, 4096, PO_POSK}, {I_POSV, 4096, PO_POSV}, {I_DW_W, 31 * 512, PO_DW_W}, {I_DW_B, 512, PO_DW_B},
    {I_LN_G, 512, PO_LN_G}, {I_LN_B, 512, PO_LN_B}, {I_PW_B, 512, PO_PW_B}, {I_BR_G, 2048, PO_BR_G}, {I_POST_G, 2048, PO_POST_G}};
static_assert(WS_PAR + (size_t)PO_END * 4 <= 1 * MiB, "parameter region");
struct Params {
    const float* in[N_IN];
    float* out;
    unsigned char* ws;
    int ph_lo, ph_hi;
};
DEV const bf16_t* PROJp(const Params& p) { return (const bf16_t*)(p.ws + WS_PROJ); }
DEV const float* PARF(const Params& p, int off) { return (const float*)(p.ws + WS_PAR) + off; }

DEV void transpose_item(const float* src, int K, int Nsrc, bf16_t* dst, int k0, int n0, bool winmap, float* scr, int lane, const float* kscale = nullptr) {
    const int np = n0 + 4 * (lane & 15); const int sc = winmap ? win_src_col(np) : np; const int scc = sc >= 0 ? sc : 0; const float mk = (float)(sc >= 0);
    f32x4 v[16];
#pragma unroll
    for (int i = 0; i < 16; ++i) v[i] = *(const f32x4*)(src + (size_t)(k0 + 4 * i + (lane >> 4)) * Nsrc + scc);
#pragma unroll
    for (int i = 0; i < 16; ++i) { float* d = scr + (4 * i + (lane >> 4)) * 65 + 4 * (lane & 15); const float mi = kscale ? mk * kscale[k0 + 4 * i + (lane >> 4)] : mk; d[0] = v[i][0] * mi; d[1] = v[i][1] * mi; d[2] = v[i][2] * mi; d[3] = v[i][3] * mi; }
    WAVE_SYNC();
    const int c = lane & 7;
#pragma unroll
    for (int j = 0; j < 8; ++j) { const int n = (lane >> 3) + 8 * j; const float* s_ = scr + (8 * c) * 65 + n;
        u32x4 o; o.x = pk2(s_[0 * 65], s_[1 * 65]); o.y = pk2(s_[2 * 65], s_[3 * 65]); o.z = pk2(s_[4 * 65], s_[5 * 65]); o.w = pk2(s_[6 * 65], s_[7 * 65]);
        *(u32x4*)(dst + (size_t)(n0 + n) * K + k0 + 8 * c) = o; }
    WAVE_SYNC();
}
constexpr int IT_WIN = (DM / 64) * (NP / 64), IT_WOUT = (DM / 64) * (DM / 64), IT_PW = (512 / 64) * (512 / 64), IT_W1 = (4096 / 64) * (128 / 64),
              IT_W2 = (128 / 64) * (128 / 64), IT_LRU = (128 / 64) * (128 / 64);
constexpr int IT_LAYER = IT_WIN + IT_WOUT + IT_PW + 2 * IT_W1 + 2 * IT_W2 + 8 * IT_LRU;
DEV void p0_item(const Params& p, int it, float* scr, int lane) {
    const int l = it / IT_LAYER; int r = it % IT_LAYER;
    unsigned char* ws = p.ws;
    if (r < IT_WIN) { const int nb = NP / 64;
        transpose_item(p.in[I_W_IN] + (size_t)l * DM * DPROJ, DM, DPROJ, (bf16_t*)(ws + WS_WIN) + (size_t)l * NP * DM, 64 * (r / nb), 64 * (r % nb), true, scr, lane, p.in[I_PRE_G] + (size_t)l * DM); return; }
    r -= IT_WIN;
    if (r < IT_WOUT) { const int nb = DM / 64; transpose_item(p.in[I_W_OUT] + (size_t)l * DM * DM, DM, DM, (bf16_t*)(ws + WS_WOUT) + (size_t)l * DM * DM, 64 * (r / nb), 64 * (r % nb), false, scr, lane); return; }
    r -= IT_WOUT;
    if (r < IT_PW) { const int nb = 512 / 64; transpose_item(p.in[I_PW_W] + (size_t)l * 512 * 512, 512, 512, (bf16_t*)(ws + WS_PW) + (size_t)l * 512 * 512, 64 * (r / nb), 64 * (r % nb), false, scr, lane); return; }
    r -= IT_PW;
    if (r < 2 * IT_W1) { const int kv = r / IT_W1; r %= IT_W1; const int nb = 128 / 64;
        transpose_item(p.in[kv ? I_W1V : I_W1K] + (size_t)l * 4096 * 128, 4096, 128, (bf16_t*)(ws + WS_W1) + (size_t)(l * 2 + kv) * 128 * 4096, 64 * (r / nb), 64 * (r % nb), false, scr, lane); return; }
    r -= 2 * IT_W1;
    if (r < 2 * IT_W2) { const int kv = r / IT_W2; r %= IT_W2; const int nb = 128 / 64;
        transpose_item(p.in[kv ? I_W2V : I_W2K] + (size_t)l * 128 * 128, 128, 128, (bf16_t*)(ws + WS_W2) + (size_t)(l * 2 + kv) * 128 * 128, 64 * (r / nb), 64 * (r % nb), false, scr, lane); return; }
    r -= 2 * IT_W2;
    { const int m = r / IT_LRU; r %= IT_LRU; const int hh = m >> 1, ax = m & 1; const int nb = 128 / 64;
        transpose_item(p.in[ax ? I_LWX : I_LWA] + (size_t)(l * 4 + hh) * 128 * 128, 128, 128, (bf16_t*)(ws + WS_LRU) + (size_t)((l * 4 + hh) * 2 + ax) * 128 * 128, 64 * (r / nb), 64 * (r % nb), false, scr, lane); }
}

DEV void p0_copy_params(const Params& p, int gtid, int gstride) {
    float* dst = (float*)(p.ws + WS_PAR);
#pragma unroll 1
    for (int s = 0; s < N_PARSEG; ++s) { const ParSeg sg = PARSEG[s]; const float* src = p.in[sg.idx]; const int n = sg.per_layer * DEPTH;
        for (int i = gtid; i < n; i += gstride) dst[sg.off + i] = src[i]; }
}

DEV void rowpass_row(const Params& p, int l, int m, int lane, bool direct0 = false) {
    f32x4 v[8];
    if (l <= 1) { const f32x4* xr = (const f32x4*)(p.in[I_X] + (size_t)m * DM) + lane;
#pragma unroll
        for (int j = 0; j < 8; ++j) v[j] = xr[64 * j]; }
    else { const u32x2* xr = (const u32x2*)((const bf16_t*)(p.ws + ((l & 1) ? WS_XB : WS_XA)) + (size_t)m * DM) + lane;
#pragma unroll
        for (int j = 0; j < 8; ++j) { const u32x2 w = xr[64 * j]; v[j] = (f32x4){u_as_f(w.x << 16), u_as_f(w.x & 0xffff0000u), u_as_f(w.y << 16), u_as_f(w.y & 0xffff0000u)}; } }
    if (l >= 1) {
        const u32x2* yr = (const u32x2*)((const bf16_t*)(p.ws + WS_Y) + (size_t)m * DM) + lane; f32x4 y[8]; float s = 0.f;
#pragma unroll
        for (int j = 0; j < 8; ++j) { const u32x2 w = yr[64 * j]; y[j] = (f32x4){u_as_f(w.x << 16), u_as_f(w.x & 0xffff0000u), u_as_f(w.y << 16), u_as_f(w.y & 0xffff0000u)};
            s += (y[j][0] * y[j][0] + y[j][1] * y[j][1]) + (y[j][2] * y[j][2] + y[j][3] * y[j][3]); }
        const float rs = RSQF(wave_sum(s) * (1.0f / DM) + EPS);
        const f32x4* g = (const f32x4*)(PARF(p, PO_POST_G) + (size_t)(l - 1) * DM) + lane;
#pragma unroll
        for (int j = 0; j < 8; ++j) v[j] = v[j] + y[j] * rs * g[64 * j];
        if (l == DEPTH) { f32x4* o = (f32x4*)(p.out + (size_t)m * DM) + lane;
#pragma unroll
            for (int j = 0; j < 8; ++j) o[64 * j] = v[j]; }
        else { u32x2* o = (u32x2*)((bf16_t*)(p.ws + ((l & 1) ? WS_XA : WS_XB)) + (size_t)m * DM) + lane;
#pragma unroll
            for (int j = 0; j < 8; ++j) o[64 * j] = (u32x2){pk2(v[j][0], v[j][1]), pk2(v[j][2], v[j][3])}; }
    }
    if (l < DEPTH) {
        float s = 0.f;
#pragma unroll
        for (int j = 0; j < 8; ++j) s += (v[j][0] * v[j][0] + v[j][1] * v[j][1]) + (v[j][2] * v[j][2] + v[j][3] * v[j][3]);
        const float wave_ss = wave_sum(s); const float rs = RSQF(wave_ss * (1.0f / DM) + EPS);
        u32x2* h = (u32x2*)((bf16_t*)(p.ws + WS_H) + (size_t)m * DM) + lane;
#pragma unroll
        for (int j = 0; j < 8; ++j) { const f32x4 t = direct0 ? v[j] : v[j] * rs; h[64 * j] = (u32x2){pk2(t[0], t[1]), pk2(t[2], t[3])}; }
        if (direct0 && lane == 0) { f32x4* sl = (f32x4*)((float*)(p.ws + WS_XSL) + (size_t)(DEPTH * 2) * T * 8 + (size_t)m * 8); sl[0] = (f32x4){wave_ss, 0.f, 0.f, 0.f}; sl[1] = (f32x4){0.f, 0.f, 0.f, 0.f}; }
    }
}

template <int NR> DEV void finalize_core(const Params& p, const f32x2 (&v)[NR], const unsigned (&zz)[NR], f32x2 g, int tok0, int mixcol, int lane) {
    float ss[NR];
#pragma unroll
    for (int r = 0; r < NR; ++r) ss[r] = v[r][0] * v[r][0] + v[r][1] * v[r][1];
#pragma unroll
    for (int o = 1; o < 64; o <<= 1)
#pragma unroll
        for (int r = 0; r < NR; ++r) ss[r] += SHFLX(ss[r], o);
#pragma unroll
    for (int r = 0; r < NR; ++r) { const float sc = RSQF(ss[r] * (1.0f / 128.0f) + EPS);
        const float z0 = u_as_f(zz[r] << 16), z1 = u_as_f(zz[r] & 0xffff0000u);
        *(unsigned*)((bf16_t*)(p.ws + WS_MIXED) + (size_t)(tok0 + r) * DM + mixcol + 2 * lane) = pk2(v[r][0] * sc * g[0] * siluf(z0), v[r][1] * sc * g[1] * siluf(z1)); }
}
template <int NR> DEV void load_zg(const Params& p, int l, unsigned (&zz)[NR], f32x2& g, int tok0, int mixcol, int zcol, int lane) {
    g = *(const f32x2*)(PARF(p, PO_BR_G) + (size_t)l * DM + mixcol + 2 * lane);
#pragma unroll
    for (int r = 0; r < NR; ++r) zz[r] = *(const unsigned*)(PROJp(p) + (size_t)(tok0 + r) * NP + zcol + 2 * lane);
}
template <int NR> DEV void finalize_vals(const Params& p, int l, const f32x2 (&v)[NR], int tok0, int mixcol, int zcol, int lane) {
    unsigned zz[NR]; f32x2 g; load_zg<NR>(p, l, zz, g, tok0, mixcol, zcol, lane); finalize_core<NR>(p, v, zz, g, tok0, mixcol, lane);
}
template <int NR> DEV void finalize_rows(const Params& p, int l, const float* rowp, int ld, int tok0, int mixcol, int zcol, int lane) {
    f32x2 v[NR];
#pragma unroll
    for (int r = 0; r < NR; ++r) v[r] = *(const f32x2*)(rowp + (size_t)r * ld + 2 * lane);
    finalize_vals<NR>(p, l, v, tok0, mixcol, zcol, lane);
}

DEV void conf_unit(const Params& p, int l, int u, unsigned char* lds) {
    const int tid = opaque_tid(), lane = tid & 63, wid = UNIFORM(tid >> 6);
    const int b = u >> 6, t0 = 32 * (u & 63), tb = b * SEQ;
    constexpr int LD = 516, YLD = 520;
    bf16_t* Y = (bf16_t*)lds;
    float* cv = (float*)(lds + 65536);
    const bf16_t* PR = PROJp(p);
    float w[31];
#pragma unroll
    for (int k = 0; k < 31; ++k) w[k] = PARF(p, PO_DW_W)[(size_t)(l * 31 + k) * 512 + tid];
    const float bias = PARF(p, PO_DW_B)[l * 512 + tid];
    __syncthreads();
    {   u32x4 vv[8], gg[8];
#pragma unroll
        for (int i = 0; i < 8; ++i) { int idx = tid + 512 * i; idx = idx < 62 * 64 ? idx : 62 * 64 - 1; const int row = idx >> 6, c8 = idx & 63; const int tl = t0 - 30 + row, tc = tl > 0 ? tl : 0;
            const bf16_t* rp = PR + (size_t)(tb + tc) * NP + 8 * c8; vv[i] = *(const u32x4*)(rp + C_CV); gg[i] = *(const u32x4*)(rp + C_CG); }
#pragma unroll
        for (int i = 0; i < 8; ++i) { int idx = tid + 512 * i; idx = idx < 62 * 64 ? idx : 62 * 64 - 1; const int row = idx >> 6, c8 = idx & 63; const float mk = (float)(t0 - 30 + row >= 0);
            u32x4 o;
#pragma unroll
            for (int q = 0; q < 4; ++q) { const float v0 = u_as_f(vv[i][q] << 16), v1 = u_as_f(vv[i][q] & 0xffff0000u), g0 = u_as_f(gg[i][q] << 16), g1 = u_as_f(gg[i][q] & 0xffff0000u);
                o[q] = pk2(v0 * sigm(g0) * mk, v1 * sigm(g1) * mk); }
            *(u32x4*)(Y + row * YLD + 8 * c8) = o; }
    }
    __syncthreads();
    {
        const int c = tid;
#pragma unroll 1
        for (int g_ = 0; g_ < (PROBE_C == 1 ? 4 : 2); ++g_) { const int g = g_ & 1;
            float yin[46];
#pragma unroll
            for (int i = 0; i < 46; ++i) yin[i] = bf2f(Y[(16 * g + i) * YLD + c]);
#pragma unroll
            for (int j = 0; j < 16; ++j) { float acc = bias;
#pragma unroll
                for (int k = 0; k < 31; ++k) acc += w[k] * yin[j + k];
                cv[(16 * g + j) * LD + c] = acc; }
        }
    }
    __syncthreads();
    const bf16_t* Bw = (const bf16_t*)(p.ws + WS_PW) + (size_t)l * 512 * 512 + (size_t)(64 * wid + (lane & 15)) * 512 + 8 * (lane >> 4);
    bf16x8 bw0[8][4];
#pragma unroll
    for (int ks = 0; ks < 8; ++ks)
#pragma unroll
        for (int nt = 0; nt < 4; ++nt) bw0[ks][nt] = *(const bf16x8*)(Bw + (size_t)(16 * nt) * 512 + 32 * ks);
    f32x4 lg0, lg1, lb0, lb1;
    { const float* lgp = PARF(p, PO_LN_G) + l * 512 + 8 * lane; const float* lbp = PARF(p, PO_LN_B) + l * 512 + 8 * lane; lg0 = *(const f32x4*)lgp; lg1 = *(const f32x4*)(lgp + 4); lb0 = *(const f32x4*)lbp; lb1 = *(const f32x4*)(lbp + 4); }
    {
#pragma unroll 1
        for (int r = 0; r < 4; ++r) { const int row = 4 * wid + r; float* rp = cv + row * LD;
            const f32x4 a = *(const f32x4*)(rp + 8 * lane), bq = *(const f32x4*)(rp + 8 * lane + 4);
            const float s = (a[0] + a[1]) + (a[2] + a[3]) + (bq[0] + bq[1]) + (bq[2] + bq[3]);
            const float mean = wave_sum(s) * (1.0f / 512.0f);
            const f32x4 da = a - mean, db = bq - mean;
            const float q = (da[0] * da[0] + da[1] * da[1]) + (da[2] * da[2] + da[3] * da[3]) + (db[0] * db[0] + db[1] * db[1]) + (db[2] * db[2] + db[3] * db[3]);
            const float rstd = RSQF(wave_sum(q) * (1.0f / 512.0f) + EPS);
            f32x4 o0, o1;
#pragma unroll
            for (int i = 0; i < 4; ++i) { o0[i] = siluf(da[i] * rstd * lg0[i] + lb0[i]); o1[i] = siluf(db[i] * rstd * lg1[i] + lb1[i]); }
            *(bf16x8*)((bf16_t*)rp + 8 * lane) = pack8(o0, o1); }
    }
    __syncthreads();
    f32x4 acc[2][4];
    {
#pragma unroll
        for (int rt = 0; rt < 2; ++rt)
#pragma unroll
            for (int nt = 0; nt < 4; ++nt) acc[rt][nt] = (f32x4){0.f, 0.f, 0.f, 0.f};
        const bf16_t* Ar = (const bf16_t*)(cv + (lane & 15) * LD) + 8 * (lane >> 4);
        bf16x8 bw1[8][4];
#pragma unroll
        for (int ks = 0; ks < 8; ++ks)
#pragma unroll
            for (int nt = 0; nt < 4; ++nt) bw1[ks][nt] = *(const bf16x8*)(Bw + (size_t)(16 * nt) * 512 + 32 * (8 + ks));
#pragma unroll
        for (int ks = 0; ks < 8; ++ks) { const bf16x8 a0 = *(const bf16x8*)(Ar + 32 * ks), a1 = *(const bf16x8*)(Ar + 16 * LD * 2 + 32 * ks);
#pragma unroll
            for (int nt = 0; nt < 4; ++nt) { acc[0][nt] = MFMA16(a0, bw0[ks][nt], acc[0][nt]); acc[1][nt] = MFMA16(a1, bw0[ks][nt], acc[1][nt]); } }
#pragma unroll
        for (int ks = 0; ks < 8; ++ks) { const bf16x8 a0 = *(const bf16x8*)(Ar + 32 * (8 + ks)), a1 = *(const bf16x8*)(Ar + 16 * LD * 2 + 32 * (8 + ks));
#pragma unroll
            for (int nt = 0; nt < 4; ++nt) { acc[0][nt] = MFMA16(a0, bw1[ks][nt], acc[0][nt]); acc[1][nt] = MFMA16(a1, bw1[ks][nt], acc[1][nt]); } }
    }
    float pbv[4]; unsigned zz[4][4]; f32x2 gg4[4];
#pragma unroll
    for (int nt = 0; nt < 4; ++nt) pbv[nt] = PARF(p, PO_PW_B)[l * 512 + 64 * wid + 16 * nt + (lane & 15)];
#pragma unroll
    for (int g = 0; g < 4; ++g) load_zg<4>(p, l, zz[g], gg4[g], tb + t0 + 4 * wid, 1536 + 128 * g, C_CZ + 128 * g, lane);
    __syncthreads();
#pragma unroll
    for (int nt = 0; nt < 4; ++nt) { const int col = 64 * wid + 16 * nt + (lane & 15);
#pragma unroll
        for (int rt = 0; rt < 2; ++rt)
#pragma unroll
            for (int i = 0; i < 4; ++i) cv[(16 * rt + (lane >> 4) * 4 + i) * LD + col] = acc[rt][nt][i] + pbv[nt]; }
    __syncthreads();
#pragma unroll
    for (int g = 0; g < 4; ++g) { f32x2 v[4];
#pragma unroll
        for (int r = 0; r < 4; ++r) v[r] = *(const f32x2*)(cv + (size_t)(4 * wid + r) * LD + 128 * g + 2 * lane);
        finalize_core<4>(p, v, zz[g], gg4[g], tb + t0 + 4 * wid, 1536 + 128 * g, lane); }
}

DEV void gla_a_unit(const Params& p, int l, int u, unsigned char* lds) {
    const int tid = opaque_tid(), lane = tid & 63, wid = UNIFORM(tid >> 6);
    const int n = u & 31, h = (u >> 5) & 3, b = u >> 7; const int tok0 = b * SEQ + 64 * n;
    float* FG = (float*)lds;
    float* GT = (float*)(lds + 4096);
    bf16_t* QD = (bf16_t*)(lds + 8192);
    bf16_t* KD = (bf16_t*)(lds + 17408);
    bf16_t* KLT = (bf16_t*)(lds + 26624);
    bf16_t* VT = (bf16_t*)(lds + 35840);
    bf16_t* AT = (bf16_t*)(lds + 54272);
    const bf16_t* PR = PROJp(p);
    const int d = tid & 63, g = tid >> 6;
    float wf[16], qv[8], kv_[8];
#pragma unroll
    for (int r = 0; r < 16; ++r) wf[r] = PARF(p, PO_FG2_W)[(size_t)(l * 16 + r) * 256 + 64 * h + d];
    const float bb = PARF(p, PO_FG2_B)[l * 256 + 64 * h + d];
#pragma unroll
    for (int i = 0; i < 8; ++i) { const int c = 8 * g + i; qv[i] = bf2f(PR[(size_t)(tok0 + c) * NP + C_GQ + 64 * h + d]); kv_[i] = bf2f(PR[(size_t)(tok0 + c) * NP + C_GK + 64 * h + d]); }
    __syncthreads();
    {
#pragma unroll
        for (int i = 0; i < 2; ++i) { const int idx = tid + 512 * i, c = idx >> 4, r = idx & 15; FG[idx] = bf2f(PR[(size_t)(tok0 + c) * NP + C_FG + r]); }
        const int j = tid >> 3, ec = (tid & 7) * 16;
#pragma unroll
        for (int q = 0; q < 2; ++q) { const bf16x8 v = *(const bf16x8*)(PR + (size_t)(tok0 + j) * NP + C_GV + 128 * h + ec + 8 * q);
#pragma unroll
            for (int i = 0; i < 8; ++i) VT[(ec + 8 * q + i) * 72 + j] = (bf16_t)v[i]; }
    }
    __syncthreads();
    float lf[8];
    {   float run = 0.f;
#pragma unroll
        for (int i = 0; i < 8; ++i) { const int c = 8 * g + i; float pre = bb;
#pragma unroll
            for (int r = 0; r < 16; ++r) pre += FG[c * 16 + r] * wf[r];
            const float ls = fminf(pre, 0.f) - LOGF(1.0f + EXPF(-fabsf(pre)));
            run += ls * (1.0f / 16.0f); lf[i] = run; }
        GT[g * 64 + d] = run;
    }
    __syncthreads();
    {   float off = 0.f, tot = 0.f;
#pragma unroll
        for (int g2 = 0; g2 < 8; ++g2) { const float t = GT[g2 * 64 + d]; tot += t; if (g2 < g) off += t; }
        bf16_t* QDg = (bf16_t*)(p.ws + WS_GQD) + (size_t)u * 64 * 64;
        u32x4 klw; unsigned short klh[8];
#pragma unroll
        for (int i = 0; i < 8; ++i) { const int c = 8 * g + i; const float bc = lf[i] + off;
            const float q = qv[i], k = kv_[i];
            const bf16_t qd = f2bf(q * 0.125f * EXPF(bc)); QD[c * 72 + d] = qd; QDg[c * 64 + d] = qd;
            KD[c * 72 + d] = f2bf(k * EXPF(-bc)); klh[i] = f2bf(k * EXPF(tot - bc)); }
        klw.x = klh[0] | ((unsigned)klh[1] << 16); klw.y = klh[2] | ((unsigned)klh[3] << 16); klw.z = klh[4] | ((unsigned)klh[5] << 16); klw.w = klh[6] | ((unsigned)klh[7] << 16);
        *(u32x4*)(KLT + d * 72 + 8 * g) = klw;
        if (g == 0) ((float*)(p.ws + WS_GDEC))[(size_t)u * 64 + d] = EXPF(tot);
    }
    __syncthreads();
    {
#pragma unroll
        for (int q = 0; q < 2; ++q) { const int tl = 2 * wid + q, ct = tl >> 2, jt = tl & 3; f32x4 acc = {0.f, 0.f, 0.f, 0.f};
            if (jt <= ct) {
#pragma unroll
                for (int ks = 0; ks < 2; ++ks) { const bf16x8 a = *(const bf16x8*)(QD + (16 * ct + (lane & 15)) * 72 + 32 * ks + 8 * (lane >> 4));
                    const bf16x8 bq = *(const bf16x8*)(KD + (16 * jt + (lane & 15)) * 72 + 32 * ks + 8 * (lane >> 4)); acc = MFMA16(a, bq, acc); } }
#pragma unroll
            for (int i = 0; i < 4; ++i) { const int c = 16 * ct + (lane >> 4) * 4 + i, j = 16 * jt + (lane & 15); AT[c * 72 + j] = f2bf(j <= c ? acc[i] : 0.f); } }
    }
    __syncthreads();
    {   const int rt = wid & 3, eh = wid >> 2; unsigned* OI = (unsigned*)(p.ws + WS_GOI) + (size_t)u * 64 * 64; bf16_t* DS = (bf16_t*)(p.ws + WS_GDS) + (size_t)u * 64 * 128;
#pragma unroll
        for (int e4 = 0; e4 < 4; ++e4) { const int et = 4 * eh + e4; f32x4 aO = {0.f, 0.f, 0.f, 0.f}, aD = {0.f, 0.f, 0.f, 0.f};
#pragma unroll
            for (int ks = 0; ks < 2; ++ks) { const int ko = 32 * ks + 8 * (lane >> 4);
                const bf16x8 fa = *(const bf16x8*)(AT + (16 * rt + (lane & 15)) * 72 + ko), fk = *(const bf16x8*)(KLT + (16 * rt + (lane & 15)) * 72 + ko);
                const bf16x8 fv = *(const bf16x8*)(VT + (16 * et + (lane & 15)) * 72 + ko);
                aO = MFMA16(fa, fv, aO); aD = MFMA16(fk, fv, aD); }
            *(u32x2*)(OI + (size_t)((wid * 4 + e4) * 64 + lane) * 2) = (u32x2){pk2(aO[0], aO[1]), pk2(aO[2], aO[3])};
            *(u32x2*)(DS + (size_t)(16 * et + (lane & 15)) * 64 + 16 * rt + (lane >> 4) * 4) = (u32x2){pk2(aD[0], aD[1]), pk2(aD[2], aD[3])}; }
    }
}

DEV void gla_scan(const Params& p, int gtid, int gstride) {
    const unsigned* DS = (const unsigned*)(p.ws + WS_GDS); const float* DEC = (const float*)(p.ws + WS_GDEC); unsigned* ST = (unsigned*)(p.ws + WS_GST);
    for (int g = gtid; g < BATCH * 4 * 4096; g += gstride) { const int bh = g >> 12, r2 = g & 4095, d = (2 * r2) & 63; float s0 = 0.f, s1 = 0.f;
        unsigned ds[32]; f32x2 dc[32];
#pragma unroll
        for (int n = 0; n < 32; ++n) { const size_t un = (size_t)bh * 32 + n; ds[n] = DS[un * 4096 + r2]; dc[n] = *(const f32x2*)(DEC + un * 64 + d); }
#pragma unroll
        for (int n = 0; n < 32; ++n) { const size_t un = (size_t)bh * 32 + n; ST[un * 4096 + r2] = pk2(s0, s1); s0 = dc[n][0] * s0 + u_as_f(ds[n] << 16); s1 = dc[n][1] * s1 + u_as_f(ds[n] & 0xffff0000u); } }
}
DEV void lru_scan(const Params& p, int gtid, int gstride) {
    const float* LE = (const float*)(p.ws + WS_LP); float* CAR = (float*)(p.ws + WS_LCAR);
    for (int g = gtid; g < BATCH * 512; g += gstride) { const int b = g >> 9, ch = g & 511; float carry = 0.f; float lh[32], lp[32];
#pragma unroll
        for (int n = 0; n < 32; ++n) { const size_t e = (size_t)(b * 32 + n) * 1024 + ch; lh[n] = LE[e]; lp[n] = LE[e + 512]; }
#pragma unroll
        for (int n = 0; n < 32; ++n) { CAR[(size_t)(b * 32 + n) * 512 + ch] = carry; carry = lp[n] * carry + lh[n]; } }
}
DEV void gla_c_wave(const Params& p, int l, int wu, int lane, float* tile) {
    const int rt = wu & 3, u = wu >> 2; const int n = u & 31, h = (u >> 5) & 3, b = u >> 7; const int tok0 = b * SEQ + 64 * n + 16 * rt;
    const bf16_t* QDg = (const bf16_t*)(p.ws + WS_GQD) + (size_t)u * 64 * 64; const bf16_t* ST = (const bf16_t*)(p.ws + WS_GST) + (size_t)u * 8192;
    const unsigned* OI = (const unsigned*)(p.ws + WS_GOI) + (size_t)u * 64 * 64;
    f32x4 acc[8]; u32x2 oi[8]; bf16x8 a[2], bs[8][2]; unsigned zz[16]; f32x2 g;
#pragma unroll
    for (int ks = 0; ks < 2; ++ks) a[ks] = *(const bf16x8*)(QDg + (16 * rt + (lane & 15)) * 64 + 32 * ks + 8 * (lane >> 4));
#pragma unroll
    for (int et = 0; et < 8; ++et)
#pragma unroll
        for (int ks = 0; ks < 2; ++ks) bs[et][ks] = *(const bf16x8*)(ST + (16 * et + (lane & 15)) * 64 + 32 * ks + 8 * (lane >> 4));
#pragma unroll
    for (int et = 0; et < 8; ++et) oi[et] = *(const u32x2*)(OI + (size_t)(((rt + 4 * (et >> 2)) * 4 + (et & 3)) * 64 + lane) * 2);
    load_zg<16>(p, l, zz, g, tok0, 128 * h, C_GZ + 128 * h, lane);
#pragma unroll
    for (int et = 0; et < 8; ++et) { acc[et] = (f32x4){u_as_f(oi[et][0] << 16), u_as_f(oi[et][0] & 0xffff0000u), u_as_f(oi[et][1] << 16), u_as_f(oi[et][1] & 0xffff0000u)};
#pragma unroll
        for (int ks = 0; ks < 2; ++ks) acc[et] = MFMA16(a[ks], bs[et][ks], acc[et]); }
    WAVE_SYNC();
#pragma unroll
    for (int et = 0; et < 8; ++et)
#pragma unroll
        for (int i = 0; i < 4; ++i) tile[((lane >> 4) * 4 + i) * 128 + 16 * et + (lane & 15)] = acc[et][i];
    WAVE_SYNC();
    f32x2 v[16];
#pragma unroll
    for (int r = 0; r < 16; ++r) v[r] = *(const f32x2*)(tile + r * 128 + 2 * lane);
    finalize_core<16>(p, v, zz, g, tok0, 128 * h, lane);
    WAVE_SYNC();
}
DEV void lru_b_wave(const Params& p, int l, int wu, int lane) {
    const int t8 = wu & 7, hh = (wu >> 3) & 3, n = (wu >> 5) & 31, b = wu >> 10; const int ch = 128 * hh + 2 * lane; const int tok0 = b * SEQ + 64 * n + 8 * t8;
    const f32x2 carry = *(const f32x2*)((const float*)(p.ws + WS_LCAR) + (size_t)(b * 32 + n) * 512 + ch);
    const unsigned* LHP = (const unsigned*)(p.ws + WS_LH) + (size_t)tok0 * 512 + ch;
    u32x2 hp[8]; f32x2 v[8]; unsigned zz[8]; f32x2 g;
#pragma unroll
    for (int r = 0; r < 8; ++r) hp[r] = *(const u32x2*)(LHP + (size_t)r * 512);
    load_zg<8>(p, l, zz, g, tok0, 512 + 128 * hh, C_LZ + 128 * hh, lane);
#pragma unroll
    for (int r = 0; r < 8; ++r) { v[r][0] = u_as_f(hp[r][0] << 16) + u_as_f(hp[r][0] & 0xffff0000u) * carry[0]; v[r][1] = u_as_f(hp[r][1] << 16) + u_as_f(hp[r][1] & 0xffff0000u) * carry[1]; }
    finalize_core<8>(p, v, zz, g, tok0, 512 + 128 * hh, lane);
}
constexpr int NW_GLAC = BATCH * 4 * 32 * 4, NW_LRUB = BATCH * 32 * 4 * 8;

DEV void lru_a_unit(const Params& p, int l, int u, unsigned char* lds) {
    const int tid = opaque_tid(), lane = tid & 63, wid = UNIFORM(tid >> 6);
    const int hh = u & 3, n = (u >> 2) & 31, b = u >> 7; const int tb = b * SEQ;
    bf16_t* XC = (bf16_t*)lds;
    float* GR = (float*)(lds + 17408);
    float* GI = (float*)(lds + 50176);
    float* SUM = (float*)(lds + 82944);
    const bf16_t* PR = PROJp(p);
    const int c = tid & 127, tg = tid >> 7, ch = 128 * hh + c;
    float xc[16];
    const int gate = wid >> 2, rt = wid & 3;
    bf16x8 bwf[4][8];
    {   const bf16_t* Bw = (const bf16_t*)(p.ws + WS_LRU) + (size_t)((l * 4 + hh) * 2 + gate) * 128 * 128;
#pragma unroll
        for (int ks = 0; ks < 4; ++ks)
#pragma unroll
            for (int jt = 0; jt < 8; ++jt) bwf[ks][jt] = *(const bf16x8*)(Bw + (size_t)(16 * jt + (lane & 15)) * 128 + 32 * ks + 8 * (lane >> 4)); }
    const float lam = PARF(p, PO_LLAM)[l * 512 + ch];
    float gbias[8];
    { const float* bias = PARF(p, gate ? PO_LBX : PO_LBA) + l * 512 + 128 * hh;
#pragma unroll
      for (int jt = 0; jt < 8; ++jt) gbias[jt] = bias[16 * jt + (lane & 15)]; }
    __syncthreads();
    {   float w4[4];
#pragma unroll
        for (int k = 0; k < 4; ++k) w4[k] = PARF(p, PO_LCONV_W)[(size_t)(l * 4 + k) * 512 + ch];
        const float cb = PARF(p, PO_LCONV_B)[l * 512 + ch]; float xin[19];
#pragma unroll
        for (int i = 0; i < 19; ++i) { const int tl = 64 * n + 16 * tg - 3 + i; const int tc = tl > 0 ? tl : 0; xin[i] = bf2f(PR[(size_t)(tb + tc) * NP + C_LX + ch]) * (float)(tl >= 0); }
#pragma unroll
        for (int j = 0; j < 16; ++j) { float a = cb;
#pragma unroll
            for (int k = 0; k < 4; ++k) a += w4[k] * xin[j + k];
            xc[j] = a; XC[(16 * tg + j) * 136 + c] = f2bf(a); }
    }
    __syncthreads();
    {   f32x4 acc[8];
#pragma unroll
        for (int i = 0; i < 8; ++i) acc[i] = (f32x4){0.f, 0.f, 0.f, 0.f};
#pragma unroll
        for (int ks = 0; ks < 4; ++ks) { const bf16x8 a = *(const bf16x8*)(XC + (16 * rt + (lane & 15)) * 136 + 32 * ks + 8 * (lane >> 4));
#pragma unroll
            for (int jt = 0; jt < 8; ++jt) acc[jt] = MFMA16(a, bwf[ks][jt], acc[jt]); }
        float* G = gate ? GI : GR;
#pragma unroll
        for (int jt = 0; jt < 8; ++jt) { const float bj = gbias[jt];
#pragma unroll
            for (int i = 0; i < 4; ++i) G[(16 * rt + (lane >> 4) * 4 + i) * 128 + 16 * jt + (lane & 15)] = sigm(acc[jt][i] + bj); }
    }
    __syncthreads();
    float hl[16], pl[16];
    {   const float sp = fmaxf(-lam, 0.f) + log1pf(expf(-fabsf(lam)));
        float hs = 0.f, ps = 1.f;
#pragma unroll
        for (int j = 0; j < 16; ++j) { const int t = 16 * tg + j; const float r = GR[t * 128 + c], ig = GI[t * 128 + c];
            const float la = -8.0f * r * sp, a = EXPF(la), uu = sqrtf(fmaxf(1.0f - a * a, 0.f)) * (ig * xc[j]);
            hs = a * hs + uu; ps *= a; hl[j] = hs; pl[j] = ps; }
        SUM[(tg * 128 + c) * 2] = hs; SUM[(tg * 128 + c) * 2 + 1] = ps;
    }
    __syncthreads();
    {   float carry = 0.f, pp = 1.f;
#pragma unroll
        for (int s = 0; s < 3; ++s) if (s < tg) { const float hs = SUM[(s * 128 + c) * 2], ps = SUM[(s * 128 + c) * 2 + 1]; carry = ps * carry + hs; pp *= ps; }
        unsigned* LHP = (unsigned*)(p.ws + WS_LH);
#pragma unroll
        for (int j = 0; j < 16; ++j) { const size_t idx = (size_t)(tb + 64 * n + 16 * tg + j) * 512 + ch; LHP[idx] = pk2(hl[j] + pl[j] * carry, pl[j] * pp); }
        if (tg == 3) { float* LE = (float*)(p.ws + WS_LP) + (size_t)(b * 32 + n) * 1024 + ch; LE[0] = hl[15] + pl[15] * carry; LE[512] = pl[15] * pp; }
    }
}
constexpr size_t WS_FLG = 49152;
#ifdef CPU_EMU
DEV void flag_signal(unsigned* f) { __syncthreads(); if (threadIdx.x == 0) *f += 1u; }
DEV void flag_wait(unsigned* f, unsigned want) { __syncthreads(); (void)f; (void)want; }
#else
DEV void flag_signal(unsigned* f) {
    asm volatile("s_waitcnt vmcnt(0)" ::: "memory"); __syncthreads();
    if (threadIdx.x == 0) { __builtin_amdgcn_fence(__ATOMIC_RELEASE, "agent"); asm volatile("s_waitcnt vmcnt(0)" ::: "memory"); __hip_atomic_fetch_add(f, 1u, __ATOMIC_RELAXED, __HIP_MEMORY_SCOPE_AGENT); }
}
DEV void flag_wait(unsigned* f, unsigned want) {
    if (threadIdx.x == 0) { unsigned sp = 0u; while (__hip_atomic_load(f, __ATOMIC_RELAXED, __HIP_MEMORY_SCOPE_AGENT) < want && ++sp < (1u << 22)) __builtin_amdgcn_s_sleep(2);
        __builtin_amdgcn_fence(__ATOMIC_ACQUIRE, "agent"); asm volatile("s_waitcnt vmcnt(0)" ::: "memory"); }
    __syncthreads();
}
#endif

#ifdef CPU_EMU
DEV unsigned part_arrive(unsigned* c) { const unsigned t = *c; *c = t + 1u; return t; }
#else
DEV unsigned part_arrive(unsigned* c) { __builtin_amdgcn_fence(__ATOMIC_RELEASE, "agent"); asm volatile("s_waitcnt vmcnt(0)" ::: "memory"); return __hip_atomic_fetch_add(c, 1u, __ATOMIC_RELAXED, __HIP_MEMORY_SCOPE_AGENT); }
#endif
DEV void cmp_unit(const Params& p, int l, int u, unsigned char* lds) {
    const int tid = opaque_tid(), lane = tid & 63, wid = UNIFORM(tid >> 6);
    const int ksl = u & 3, grp = u >> 2; const int rt = grp % 9, b = (grp / 9) % BATCH, kv = grp / (9 * BATCH); const int n0 = 15 * rt, tb = b * SEQ;
    bf16_t* ZS = (bf16_t*)lds;
    bf16_t* POSF = (bf16_t*)(lds + 32768);
    bf16_t* HID = (bf16_t*)(lds + 36864);
    unsigned* TICK = (unsigned*)(lds + 43008);
    const int r = lane & 15, kq = lane >> 4;
    bf16x8 bw[32], w2f[4];
    { const bf16_t* bp = (const bf16_t*)(p.ws + WS_W1) + (size_t)(l * 2 + kv) * 128 * 4096 + (size_t)(16 * wid + r) * 4096 + 1024 * ksl + 8 * kq;
#pragma unroll
      for (int i = 0; i < 32; ++i) bw[i] = *(const bf16x8*)(bp + 32 * i); }
    { const bf16_t* bp2 = (const bf16_t*)(p.ws + WS_W2) + (size_t)(l * 2 + kv) * 128 * 128 + (size_t)(16 * wid + r) * 128 + 8 * kq;
#pragma unroll
      for (int ks = 0; ks < 4; ++ks) w2f[ks] = *(const bf16x8*)(bp2 + 32 * ks); }
    __syncthreads();
#pragma unroll
    for (int i = 0; i < 4; ++i) { int idx = tid + 512 * i; idx = idx < 15 * 8 * 16 ? idx : 15 * 8 * 16 - 1; const int c8 = idx & 15, t8 = (idx >> 4) & 7, rr = idx >> 7;
        const int tl = 16 * (n0 + rr) + 8 * ksl + t8; const int tc = tl < SEQ ? tl : SEQ - 1;
        u32x4 v = *(const u32x4*)((const bf16_t*)(p.ws + WS_KVC) + (size_t)(tb + tc) * 256 + (kv ? 128 : 0) + 8 * c8);
        if (tl >= SEQ) v = (u32x4){0u, 0u, 0u, 0u};
        *(u32x4*)(ZS + (rr * 8 + t8) * 128 + 8 * (c8 ^ rr)) = v; }
    if (tid < 128) { const float* pos = PARF(p, kv ? PO_POSV : PO_POSK) + (size_t)l * 4096 + 1024 * ksl + 8 * tid;
        const f32x4 a = *(const f32x4*)pos, bq = *(const f32x4*)(pos + 4); *(bf16x8*)(POSF + 8 * tid) = pack8(a, bq); }
    __syncthreads();
    f32x4 acc = {0.f, 0.f, 0.f, 0.f};
#pragma unroll
    for (int i = 0; i < 32; ++i) { const int t8 = i >> 2, c = 4 * (i & 3) + kq;
        const bf16_t* ap = r < 15 ? ZS + (r * 8 + t8) * 128 + 8 * (c ^ r) : POSF + 32 * i + 8 * kq;
        const bf16x8 a = *(const bf16x8*)ap; acc = MFMA16(a, bw[i], acc); }
    float* PART = (float*)(p.ws + WS_CPART) + (size_t)grp * 4 * 2048;
    *(f32x4*)(PART + (size_t)ksl * 2048 + (wid * 64 + lane) * 4) = acc;
#ifndef CPU_EMU
    asm volatile("s_waitcnt vmcnt(0)" ::: "memory");
#endif
    __syncthreads();
    if (tid == 0) *TICK = part_arrive((unsigned*)(p.ws + WS_CCNT) + (size_t)l * (2 * BATCH * 9) + grp);
    __syncthreads();
    if (*TICK != 3u) return;
#ifndef CPU_EMU
    if (tid == 0) { __builtin_amdgcn_fence(__ATOMIC_ACQUIRE, "agent"); asm volatile("s_waitcnt vmcnt(0)" ::: "memory"); }
#endif
    __syncthreads();
    {   f32x4 s4 = {0.f, 0.f, 0.f, 0.f};
#pragma unroll
        for (int q = 0; q < 4; ++q) s4 = s4 + *(const f32x4*)(PART + (size_t)q * 2048 + (wid * 64 + lane) * 4);
        const float posv = SHFL(s4[3], 48 + (lane & 15));
#pragma unroll
        for (int i = 0; i < 4; ++i) { const int row = (lane >> 4) * 4 + i; HID[row * 136 + 16 * wid + (lane & 15)] = f2bf(siluf(s4[i] + posv)); }
    }
    __syncthreads();
    {   f32x4 a2 = {0.f, 0.f, 0.f, 0.f};
#pragma unroll
        for (int ks = 0; ks < 4; ++ks) { const bf16x8 a = *(const bf16x8*)(HID + (lane & 15) * 136 + 32 * ks + 8 * (lane >> 4)); a2 = MFMA16(a, w2f[ks], a2); }
        bf16_t* KC = (bf16_t*)(p.ws + WS_KCMP) + (size_t)(kv * BATCH + b) * 128 * 128;
#pragma unroll
        for (int i = 0; i < 4; ++i) { const int row = (lane >> 4) * 4 + i, nn = n0 + row;
            if (row < 15 && nn < 128) KC[nn * 128 + 16 * wid + (lane & 15)] = nn < 127 ? f2bf(a2[i]) : (bf16_t)0; }
    }
    flag_signal((unsigned*)(p.ws + WS_FLG) + (size_t)(l * BATCH + b) * 64);
}

namespace nsa {
constexpr int SHM_K = 16384, SHM_V = 16384;
constexpr int L_V = 0, L_K = 32768, L_WSC = 65536, L_SELM = 67584, L_UNI = 67840, L_CS = 68096, L_IMP = 133632;
constexpr float SCALE = 0.08838834764831845f, C2 = 1.4426950408889634f * SCALE, THR = 8.f;
#define KSWZ(row, colB) ((row) * 256 + ((colB) ^ (((row) & 7) << 4)))
DEV int v_st(int k, int c) { const int kk = (k & ~0xC) | ((k & 4) << 1) | ((k & 8) >> 1); return ((kk >> 3) * 4 + (c >> 5)) * 512 + ((kk & 7) * 32 + (c & 31)) * 2; }
DEV int v_rd_base(int lane) { return ((lane & 3) << 3) | (((lane >> 2) & 3) << 6) | (((lane >> 4) & 1) << 5) | (((lane >> 5) & 1) << 8); }
DEV int crow(int r, int hi) { return (r & 3) + 8 * (r >> 2) + 4 * hi; }
DEV void partialSM(f32x16& p0, f32x16& p1, float& m_reg, float& alpha) {
    float pmax = p0[0];
#pragma unroll
    for (int r = 1; r < 16; ++r) pmax = fmaxf(pmax, p0[r]);
#pragma unroll
    for (int r = 0; r < 16; ++r) pmax = fmaxf(pmax, p1[r]);
    { auto rr = PLSWAP(f_as_u(pmax), f_as_u(pmax)); pmax = fmaxf(u_as_f(rr[0]), u_as_f(rr[1])); }
    float mn;
    if (ALL((pmax - m_reg) * SCALE <= THR)) { mn = m_reg; alpha = 1.f; }
    else { mn = fmaxf(m_reg, pmax); alpha = EXP2F((m_reg - mn) * C2); m_reg = mn; }
    const float mnL = -mn * C2;
#pragma unroll
    for (int r = 0; r < 16; ++r) { p0[r] = EXP2F(fmaf(p0[r], C2, mnL)); p1[r] = EXP2F(fmaf(p1[r], C2, mnL)); }
}
DEV void packP(const f32x16& p0, const f32x16& p1, bf16x8& pa0, bf16x8& pa1, bf16x8& pa2, bf16x8& pa3) {
#define PK4(P, B_, OUT) do { unsigned a0 = cvtpk(P[B_ + 0], P[B_ + 1]), a1 = cvtpk(P[B_ + 2], P[B_ + 3]); unsigned b0 = cvtpk(P[B_ + 4], P[B_ + 5]), b1 = cvtpk(P[B_ + 6], P[B_ + 7]); \
        auto r0 = PLSWAP(a0, b0); auto r1 = PLSWAP(a1, b1); u32x4 w = {r0[0], r1[0], r0[1], r1[1]}; OUT = __builtin_bit_cast(bf16x8, w); } while (0)
    PK4(p0, 0, pa0); PK4(p0, 8, pa1); PK4(p1, 0, pa2); PK4(p1, 8, pa3);
#undef PK4
}
DEV float rowsum2(const f32x16& p0, const f32x16& p1) {
    float ps = 0.f;
#pragma unroll
    for (int r = 0; r < 16; ++r) ps += p0[r];
#pragma unroll
    for (int r = 0; r < 16; ++r) ps += p1[r];
    auto rr = PLSWAP(f_as_u(ps), f_as_u(ps)); return u_as_f(rr[0]) + u_as_f(rr[1]);
}
template <int KB> DEV void qkt(f32x16& p0, f32x16& p1, const unsigned char* K_lds, int r32, int hi, const bf16x8* qr) {
#pragma unroll
    for (int r = 0; r < 16; ++r) { p0[r] = 0.f; p1[r] = 0.f; }
    const unsigned char* kb[4];
#pragma unroll
    for (int dd = 0; dd < 4; ++dd) kb[dd] = K_lds + KB * SHM_K + KSWZ(r32, (dd * 16 + hi * 8) * 2);
#pragma unroll
    for (int d0 = 0; d0 < 8; ++d0) { const unsigned char* a = kb[d0 & 3] + (d0 >> 2) * 128;
        const bf16x8 b0 = *(const bf16x8*)a, b1 = *(const bf16x8*)(a + 32 * 256);
        p0 = MFMA32(b0, qr[d0], p0); p1 = MFMA32(b1, qr[d0], p1); }
}
template <int VB> DEV void pv_tile(f32x16* o, unsigned vb0, bf16x8 pa0, bf16x8 pa1, bf16x8 pa2, bf16x8 pa3) {
#define PV_D0(d0) do { s16x4 l0, l1, l2, l3, h0, h1, h2, h3; constexpr int b_ = VB * SHM_V + (d0) * 512; \
        TRREAD(l0, vb0, b_); TRREAD(h0, vb0, b_ + 2048); TRREAD(l1, vb0, b_ + 4096); TRREAD(h1, vb0, b_ + 6144); TRREAD(l2, vb0, b_ + 8192); TRREAD(h2, vb0, b_ + 10240); TRREAD(l3, vb0, b_ + 12288); TRREAD(h3, vb0, b_ + 14336); \
        LGKM0(); SBAR(); \
        o[d0] = MFMA32(pa0, ((bf16x8){l0[0], l0[1], l0[2], l0[3], h0[0], h0[1], h0[2], h0[3]}), o[d0]); \
        o[d0] = MFMA32(pa1, ((bf16x8){l1[0], l1[1], l1[2], l1[3], h1[0], h1[1], h1[2], h1[3]}), o[d0]); \
        o[d0] = MFMA32(pa2, ((bf16x8){l2[0], l2[1], l2[2], l2[3], h2[0], h2[1], h2[2], h2[3]}), o[d0]); \
        o[d0] = MFMA32(pa3, ((bf16x8){l3[0], l3[1], l3[2], l3[3], h3[0], h3[1], h3[2], h3[3]}), o[d0]); } while (0)
    PV_D0(0); PV_D0(1); PV_D0(2); PV_D0(3);
#undef PV_D0
}
struct KVRegs { bf16x8 k0, k1, v0, v1; };
DEV void kv_load(KVRegs& r, const bf16_t* Kg, const bf16_t* Vg, size_t ld, int tid) {
    const int sr = tid >> 4, sc = (tid & 15) * 8;
    r.k0 = *(const bf16x8*)(Kg + (size_t)sr * ld + sc); r.k1 = *(const bf16x8*)(Kg + (size_t)(32 + sr) * ld + sc);
    r.v0 = *(const bf16x8*)(Vg + (size_t)sr * ld + sc); r.v1 = *(const bf16x8*)(Vg + (size_t)(32 + sr) * ld + sc);
}
DEV void kv_write(const KVRegs& r, unsigned char* lds, int kbuf, int vbuf, int tid) {
    const int sr = tid >> 4, sc = (tid & 15) * 8;
    unsigned char* Kl = lds + L_K + kbuf * SHM_K; unsigned char* Vl = lds + L_V + vbuf * SHM_V; const int kws = KSWZ(sr, sc * 2);
    *(bf16x8*)(Kl + kws) = r.k0; *(bf16x8*)(Kl + kws + 32 * 256) = r.k1;
    *(bf16x8*)(Vl + v_st(sr, sc)) = r.v0; *(bf16x8*)(Vl + v_st(32 + sr, sc)) = r.v1;
}
DEV void stage_kv(const bf16_t* Kg, const bf16_t* Vg, size_t ld, unsigned char* lds, int kbuf, int vbuf, int tid) { KVRegs r; kv_load(r, Kg, Vg, ld, tid); kv_write(r, lds, kbuf, vbuf, tid); }
DEV void kv_dma(const bf16_t* Kg, const bf16_t* Vg, size_t ld, unsigned char* lds, int buf, int wid, int lane) {
#pragma unroll
    for (int ii = 0; ii < 2; ++ii) { const int i = 2 * wid + ii, L = i * 1024 + lane * 16;
        { const int row = L >> 8, c = (L >> 4) & 15, cs = c ^ (row & 7); GLDS16(Kg + (size_t)row * ld + cs * 8, lds + L_K + buf * SHM_K + i * 1024); }
        { const int sb = L >> 9, o_ = L & 511, kk = (sb >> 2) * 8 + (o_ >> 6), c = (sb & 3) * 32 + ((o_ & 63) >> 1); const int k = (kk & ~0xC) | ((kk & 4) << 1) | ((kk & 8) >> 1);
          GLDS16(Vg + (size_t)k * ld + c, lds + L_V + buf * SHM_V + i * 1024); } }
}
}

#ifndef NSA_SPLIT_QB
#define NSA_SPLIT_QB 16
#endif
DEV int nsa_nparts(int qb) { return qb < NSA_SPLIT_QB ? 1 : 2; }
DEV void nsa_range(int qb, int k, int K, int& lo, int& hi_) {
    const int ns = qb + 1, nw = ns < 9 ? ns : 9;
    if (K == 1) { lo = 0; hi_ = ns; return; }
    const int tgt2 = (K * 5 + 2 + 2 * (nw + ns)) / K;
    int al = (tgt2 - 5 - 2 * nw) / 2; if (al < 0) al = 0;
    int a0 = K == 2 ? ns - al : (tgt2 - 7) / 2; if (a0 < 1) a0 = 1; if (a0 > ns - al) a0 = ns - al;
    if (k == 0) { lo = 0; hi_ = a0; } else if (k == K - 1) { lo = ns - al; hi_ = ns; } else { lo = a0; hi_ = ns - al; }
}
constexpr size_t NSA_PART_BYTES = 256 * 128 * 4;
DEV int nsa_frag_idx(int wid, int lane, int d0, int q) { return (((wid * 4 + d0) * 4 + q) * 64 + lane) * 4; }
DEV void nsa_part(const Params& p, int l, int b, int qb, int k, int K, unsigned char* lds, bool dry = false) {
    using namespace nsa;
    const int tid = opaque_tid(), lane = tid & 63, wid = UNIFORM(tid >> 6), r32 = lane & 31, hi = lane >> 5;
    const int tb = b * SEQ, t0 = 64 * qb;
    const int head = wid >> 1, tau = 32 * (wid & 1) + r32, pos = t0 + tau;
    const bf16_t* PR = PROJp(p); const bf16_t* KVS = (const bf16_t*)(p.ws + WS_KVC) + (size_t)1 * T * 256; const bf16_t* KVW = (const bf16_t*)(p.ws + WS_KVC) + (size_t)2 * T * 256;
    float* wsc = (float*)(lds + L_WSC) + wid * 64; float* li_l = wsc; float* al_l = wsc + 32;
    unsigned* SELM = (unsigned*)(lds + L_SELM); unsigned* UNI = (unsigned*)(lds + L_UNI);
    float* CS = (float*)(lds + L_CS); float* IMP = (float*)(lds + L_IMP);
    const unsigned vb0 = LDS_ADDR(lds + L_V) + v_rd_base(lane);
    const int pid0 = (b * 32 + qb) * 3;
    float* ACCb = (float*)(p.ws + WS_NACC + (size_t)(pid0 + k) * NSA_PART_BYTES);
    float* SLCb = (float*)(p.ws + WS_NSLC + (size_t)(pid0 + k) * NSA_PART_BYTES);
    const bool has_win = (k == K - 1), has_cmp = (k == 0);
    bf16x8 qr[8];
#pragma unroll
    for (int d0 = 0; d0 < 8; ++d0) qr[d0] = *(const bf16x8*)(PR + (size_t)(tb + pos) * NP + C_NQ + 128 * head + 16 * d0 + 8 * hi);
    float gs[3];
#pragma unroll
    for (int i = 0; i < 3; ++i) gs[i] = sigm(bf2f(PR[(size_t)(tb + pos) * NP + C_NG + 3 * head + i]));
    f32x16 o[4]; float m_reg, l_reg, alpha; bf16x8 pa0, pa1, pa2, pa3;
    const float NEG = -__builtin_inff();
#define ZERO_O() do { _Pragma("unroll") for (int d_ = 0; d_ < 4; ++d_) _Pragma("unroll") for (int r = 0; r < 16; ++r) o[d_][r] = 0.f; } while (0)
#define RESC(a) do { if (ANY((a) < 1.f)) { if (hi == 0) al_l[r32] = (a); WAVE_SYNC(); \
        _Pragma("unroll") for (int d_ = 0; d_ < 4; ++d_) _Pragma("unroll") for (int r = 0; r < 16; ++r) o[d_][r] *= al_l[crow(r, hi)]; WAVE_SYNC(); } } while (0)
#define ROWFAC(fac, f) do { WAVE_SYNC(); if (hi == 0) li_l[r32] = (fac); WAVE_SYNC(); _Pragma("unroll") for (int r = 0; r < 16; ++r) f[r] = li_l[crow(r, hi)]; WAVE_SYNC(); } while (0)
    if (has_win) {   m_reg = -1e30f; l_reg = 0.f; ZERO_O();
        const int jlo = qb - 8 > 0 ? qb - 8 : 0; int cur = 0;
        __syncthreads();
        kv_dma(KVW + (size_t)(tb + 64 * jlo) * 256, KVW + (size_t)(tb + 64 * jlo) * 256 + 128, 256, lds, 0, wid, lane);
        DMA_WAIT(); __syncthreads();
#pragma unroll 1
        for (int j = jlo; j <= qb; ++j) {
            if (j < qb) kv_dma(KVW + (size_t)(tb + 64 * (j + 1)) * 256, KVW + (size_t)(tb + 64 * (j + 1)) * 256 + 128, 256, lds, cur ^ 1, wid, lane);
            f32x16 p0, p1; qkt<0>(p0, p1, lds + L_K + cur * SHM_K, r32, hi, qr);
            if (j == qb || j == qb - 8) { const int dq = pos - 64 * j;
#pragma unroll
                for (int r = 0; r < 16; ++r) { const int c = crow(r, hi); if ((unsigned)(dq - c) >= 512u) p0[r] = NEG; if ((unsigned)(dq - c - 32) >= 512u) p1[r] = NEG; } }
            partialSM(p0, p1, m_reg, alpha); RESC(alpha);
            l_reg = l_reg * alpha + rowsum2(p0, p1);
            packP(p0, p1, pa0, pa1, pa2, pa3); pv_tile<0>(o, vb0 + cur * SHM_V, pa0, pa1, pa2, pa3);
            DMA_WAIT(); __syncthreads(); cur ^= 1;
        }
        float f[16]; ROWFAC(gs[2] / l_reg, f);
        float* ap = ACCb; LAUNDER(ap);
#pragma unroll
        for (int d0 = 0; d0 < 4; ++d0)
#pragma unroll
            for (int q = 0; q < 4; ++q) *(f32x4*)(ap + nsa_frag_idx(wid, lane, d0, q)) = (f32x4){o[d0][4 * q] * f[4 * q], o[d0][4 * q + 1] * f[4 * q + 1], o[d0][4 * q + 2] * f[4 * q + 2], o[d0][4 * q + 3] * f[4 * q + 3]};
    }
    flag_wait((unsigned*)(p.ws + WS_FLG) + (size_t)(l * BATCH + b) * 64, 18u);
    {   const bf16_t* KC = (const bf16_t*)(p.ws + WS_KCMP) + (size_t)(0 * BATCH + b) * 128 * 128; const bf16_t* VC = (const bf16_t*)(p.ws + WS_KCMP) + (size_t)(1 * BATCH + b) * 128 * 128;
        stage_kv(KC, VC, 128, lds, 0, 0, tid); stage_kv(KC + 64 * 128, VC + 64 * 128, 128, lds, 1, 1, tid);
        if (tid == 0) *UNI = 0u;
    }
    __syncthreads();
    {
        float mx = -1e30f, lsum = 0.f;
#define CMASK(P0, P1, kb) do { _Pragma("unroll") for (int r = 0; r < 16; ++r) { const int n = 64 * (kb) + crow(r, hi); \
            if (pos < 16 * n + 31) P0[r] = NEG; if (pos < 16 * (n + 32) + 31 || n + 32 >= 127) P1[r] = NEG; } } while (0)
#define CPASS1(kb) do { f32x16 p0, p1; qkt<kb>(p0, p1, lds + L_K, r32, hi, qr); CMASK(p0, p1, kb); float tm = mx; \
            _Pragma("unroll") for (int r = 0; r < 16; ++r) tm = fmaxf(tm, fmaxf(p0[r], p1[r])); \
            { auto rr = PLSWAP(f_as_u(tm), f_as_u(tm)); tm = fmaxf(u_as_f(rr[0]), u_as_f(rr[1])); } \
            const float mnL = -tm * C2; \
            _Pragma("unroll") for (int r = 0; r < 16; ++r) { p0[r] = EXP2F(fmaf(p0[r], C2, mnL)); p1[r] = EXP2F(fmaf(p1[r], C2, mnL)); } \
            lsum = lsum * EXP2F((mx - tm) * C2) + rowsum2(p0, p1); mx = tm; } while (0)
        CPASS1(0); CPASS1(1);
        const float inv = lsum > 0.f ? 1.0f / lsum : 0.f; const float mnL2 = -mx * C2;
        float* csr = CS + (size_t)((head * 64 + tau) * 32) * 2;
        ZERO_O();
#define CSW(P, s) do { _Pragma("unroll") for (int q = 0; q < 4; ++q) { const int g = 8 * (s) + 2 * q + hi; *(f32x2*)(csr + 2 * g) = (f32x2){(P[4 * q] + P[4 * q + 1]) + (P[4 * q + 2] + P[4 * q + 3]), P[4 * q + 3]}; } } while (0)
#define CPASS2(kb) do { f32x16 p0, p1; qkt<kb>(p0, p1, lds + L_K, r32, hi, qr); CMASK(p0, p1, kb); \
            _Pragma("unroll") for (int r = 0; r < 16; ++r) { p0[r] = EXP2F(fmaf(p0[r], C2, mnL2)) * inv; p1[r] = EXP2F(fmaf(p1[r], C2, mnL2)) * inv; } \
            CSW(p0, 2 * (kb)); CSW(p1, 2 * (kb) + 1); if (has_cmp) { packP(p0, p1, pa0, pa1, pa2, pa3); pv_tile<kb>(o, vb0, pa0, pa1, pa2, pa3); } } while (0)
        CPASS2(0); CPASS2(1);
#undef CSW
#undef CPASS1
#undef CPASS2
#undef CMASK
        if (has_cmp) {
            float f[16]; ROWFAC(gs[0], f);
            float* ap = ACCb; LAUNDER(ap);
#pragma unroll
            for (int d0 = 0; d0 < 4; ++d0)
#pragma unroll
                for (int q = 0; q < 4; ++q) { f32x4* a4 = (f32x4*)(ap + nsa_frag_idx(wid, lane, d0, q)); f32x4 v = (f32x4){o[d0][4 * q] * f[4 * q], o[d0][4 * q + 1] * f[4 * q + 1], o[d0][4 * q + 2] * f[4 * q + 2], o[d0][4 * q + 3] * f[4 * q + 3]};
                    if (has_win) v = v + *a4; *a4 = v; }
        }
    }
    __syncthreads();
    {
        const int tk = tid >> 3, j4 = (tid & 7) * 4;
#pragma unroll
        for (int i = 0; i < 4; ++i) { const int j = j4 + i; float v = 0.f;
#pragma unroll
            for (int hd = 0; hd < 4; ++hd) { const float* c2 = CS + (size_t)((hd * 64 + tk) * 32) * 2; v += c2[2 * j]; if (j > 0) v += c2[2 * (j - 1) + 1]; }
            const bool forced = (j == 0) || (j == qb) || (j == qb - 1);
            IMP[tk * 32 + j] = j > qb ? NEG : (forced ? 1000.0f : v); }
    }
    __syncthreads();
    {   const int tk = tid >> 3, j4 = (tid & 7) * 4; unsigned bits = 0u;
#pragma unroll
        for (int i = 0; i < 4; ++i) { const int j = j4 + i; const float vj = IMP[tk * 32 + j]; int cnt = 0;
#pragma unroll 8
            for (int j2 = 0; j2 < 32; ++j2) { const float v2 = IMP[tk * 32 + j2]; cnt += (v2 > vj || (v2 == vj && j2 < j)) ? 1 : 0; }
            if (cnt < 16 && j <= qb) bits |= 1u << j; }
        bits |= SHFLXU(bits, 1); bits |= SHFLXU(bits, 2); bits |= SHFLXU(bits, 4);
        if ((tid & 7) == 0) SELM[tk] = bits;
    }
    __syncthreads();
    if (wid == 0) { unsigned v = SELM[lane];
#pragma unroll
        for (int o_ = 1; o_ < 64; o_ <<= 1) v |= SHFLXU(v, o_);
        if (lane == 0) *UNI = v; }
    __syncthreads();
    const unsigned selm = SELM[tau], uni = *UNI;
#ifdef CPU_EMU
    { extern unsigned g_dbg_selm[64]; extern float g_dbg_imp[64 * 32]; if (tid < 64) g_dbg_selm[tid] = SELM[tid]; for (int i = tid; i < 2048; i += 512) g_dbg_imp[i] = IMP[i]; }
#endif
    {   m_reg = -1e30f; l_reg = 0.f; ZERO_O();
        int jlo, jhi; nsa_range(qb, k, K, jlo, jhi);
        int j = jlo; while (j < jhi && !((uni >> j) & 1u)) ++j;
        int cur = 0;
        __syncthreads();
        if (j < jhi) kv_dma(KVS + (size_t)(tb + 64 * j) * 256, KVS + (size_t)(tb + 64 * j) * 256 + 128, 256, lds, 0, wid, lane);
        DMA_WAIT(); __syncthreads();
#pragma unroll 1
        while (j < jhi) {
            int jn = j + 1; while (jn < jhi && !((uni >> jn) & 1u)) ++jn;
            if (jn < jhi) kv_dma(KVS + (size_t)(tb + 64 * jn) * 256, KVS + (size_t)(tb + 64 * jn) * 256 + 128, 256, lds, cur ^ 1, wid, lane);
            f32x16 p0, p1; qkt<0>(p0, p1, lds + L_K + cur * SHM_K, r32, hi, qr);
            if (!((selm >> j) & 1u)) {
#pragma unroll
                for (int r = 0; r < 16; ++r) { p0[r] = NEG; p1[r] = NEG; } }
            else if (j == qb) {
#pragma unroll
                for (int r = 0; r < 16; ++r) { const int c = crow(r, hi); if (c > tau) p0[r] = NEG; if (c + 32 > tau) p1[r] = NEG; } }
            partialSM(p0, p1, m_reg, alpha); RESC(alpha);
            l_reg = l_reg * alpha + rowsum2(p0, p1);
            packP(p0, p1, pa0, pa1, pa2, pa3); pv_tile<0>(o, vb0 + cur * SHM_V, pa0, pa1, pa2, pa3);
            DMA_WAIT(); __syncthreads(); cur ^= 1;
            j = jn;
        }
        if (K == 1) {
            float f[16]; ROWFAC(gs[1] / l_reg, f);
            __syncthreads();
            float* OT = (float*)lds + (size_t)(32 * wid + 4 * hi) * 128 + r32; const float* ab = ACCb; LAUNDER(ab);
#pragma unroll
            for (int d0 = 0; d0 < 4; ++d0)
#pragma unroll
                for (int q = 0; q < 4; ++q) { const f32x4 v = *(const f32x4*)(ab + nsa_frag_idx(wid, lane, d0, q));
#pragma unroll
                    for (int i = 0; i < 4; ++i) { const int r = 4 * q + i; OT[((r & 3) + 8 * (r >> 2)) * 128 + d0 * 32] = v[i] + o[d0][r] * f[r]; } }
        } else {
        float* sb = SLCb; LAUNDER(sb);
#pragma unroll
        for (int d0 = 0; d0 < 4; ++d0)
#pragma unroll
            for (int q = 0; q < 4; ++q) *(f32x4*)(sb + nsa_frag_idx(wid, lane, d0, q)) = (f32x4){o[d0][4 * q], o[d0][4 * q + 1], o[d0][4 * q + 2], o[d0][4 * q + 3]};
        if (hi == 0) *(f32x2*)((float*)(p.ws + WS_NML) + (size_t)((pid0 + k) * 256 + 32 * wid + r32) * 2) = (f32x2){m_reg, l_reg};
        }
    }
    if (K != 1) {
    if (dry) return;
    unsigned* TICK = (unsigned*)(lds + L_UNI + 16);
#ifndef CPU_EMU
    asm volatile("s_waitcnt vmcnt(0)" ::: "memory");
#endif
    __syncthreads();
    if (tid == 0) *TICK = part_arrive((unsigned*)(p.ws + WS_NCNT) + (size_t)l * BATCH * 32 + b * 32 + qb);
    __syncthreads();
    const unsigned ticket = *TICK;
    if (ticket != (unsigned)(K - 1)) return;
#ifndef CPU_EMU
    if (tid == 0) { __builtin_amdgcn_fence(__ATOMIC_ACQUIRE, "agent"); asm volatile("s_waitcnt vmcnt(0)" ::: "memory"); }
#endif
    __syncthreads();
    {   const float* ML = (const float*)(p.ws + WS_NML) + (size_t)(pid0 * 256 + 32 * wid + r32) * 2;
        float mk[3], lk[3]; float M = -1e30f;
#pragma unroll
        for (int kk = 0; kk < 3; ++kk) { const int kc = kk < K ? kk : 0; const f32x2 v = *(const f32x2*)(ML + (size_t)kc * 512); mk[kk] = kk < K ? v[0] : -1e30f; lk[kk] = kk < K ? v[1] : 0.f; M = fmaxf(M, mk[kk]); }
        float L = 0.f;
#pragma unroll
        for (int kk = 0; kk < 3; ++kk) { mk[kk] = EXP2F((mk[kk] - M) * C2); L += mk[kk] * lk[kk]; }
        const float gl = gs[1] / L;
        ZERO_O();
#pragma unroll 1
        for (int kk = 0; kk < K; ++kk) { const float fk = (kk == 0 ? mk[0] : (kk == 1 ? mk[1] : mk[2])) * gl; float f[16]; ROWFAC(fk, f);
            const float* sb = (const float*)(p.ws + WS_NSLC + (size_t)(pid0 + kk) * NSA_PART_BYTES); LAUNDER(sb);
#pragma unroll
            for (int d0 = 0; d0 < 4; ++d0)
#pragma unroll
                for (int q = 0; q < 4; ++q) { const f32x4 v = *(const f32x4*)(sb + nsa_frag_idx(wid, lane, d0, q));
#pragma unroll
                    for (int i = 0; i < 4; ++i) o[d0][4 * q + i] += v[i] * f[4 * q + i]; } }
#pragma unroll 1
        for (int s2 = 0; s2 < 2; ++s2) { const int kk = s2 == 0 ? 0 : K - 1; if (s2 == 1 && K == 1) break;
            const float* ab = (const float*)(p.ws + WS_NACC + (size_t)(pid0 + kk) * NSA_PART_BYTES); LAUNDER(ab);
#pragma unroll
            for (int d0 = 0; d0 < 4; ++d0)
#pragma unroll
                for (int q = 0; q < 4; ++q) { const f32x4 v = *(const f32x4*)(ab + nsa_frag_idx(wid, lane, d0, q));
#pragma unroll
                    for (int i = 0; i < 4; ++i) o[d0][4 * q + i] += v[i]; } }
        __syncthreads();
        float* OT = (float*)lds + (size_t)(32 * wid + 4 * hi) * 128 + r32;
#pragma unroll
        for (int r = 0; r < 16; ++r)
#pragma unroll
            for (int d0 = 0; d0 < 4; ++d0) OT[((r & 3) + 8 * (r >> 2)) * 128 + d0 * 32] = o[d0][r];
    }
    }
    __syncthreads();
    {   const float* OT = (const float*)lds; const int R0 = 32 * wid, hd = R0 >> 6, tk0 = R0 & 63;
        unsigned zz[4][8]; f32x2 g;
#pragma unroll
        for (int r8 = 0; r8 < 4; ++r8) load_zg<8>(p, l, zz[r8], g, tb + t0 + tk0 + 8 * r8, 1024 + 128 * hd, C_NZ + 128 * hd, lane);
#pragma unroll
        for (int r8 = 0; r8 < 4; ++r8) { f32x2 v[8];
#pragma unroll
            for (int r = 0; r < 8; ++r) v[r] = *(const f32x2*)(OT + (size_t)(R0 + 8 * r8 + r) * 128 + 2 * lane);
            finalize_core<8>(p, v, zz[r8], g, tb + t0 + tk0 + 8 * r8, 1024 + 128 * hd, lane); }
    }
#undef ZERO_O
#undef RESC
#undef ROWFAC
}
constexpr int NU_NSA_A = BATCH * 32, NU_NSA_B = BATCH * (32 - NSA_SPLIT_QB);
DEV void nsa_unit_a(const Params& p, int l, int u, unsigned char* lds) { const int b = u % BATCH, qb = 31 - u / BATCH; const int K = nsa_nparts(qb); nsa_part(p, l, b, qb, K - 1, K, lds); }
DEV void nsa_unit_b(const Params& p, int l, int u, unsigned char* lds) { const int b = u % BATCH, qb = 31 - u / BATCH; nsa_part(p, l, b, qb, 0, 2, lds); }

constexpr int NU_CMP = 2 * BATCH * 9 * 4, NU_CONF = BATCH * 64, NU_LRUA = BATCH * 128, NU_GLAA = BATCH * 128;
constexpr int NU_CONV = (IT_LAYER + 7) / 8;
constexpr int NU_MX = NU_CMP + NU_NSA_A + NU_CONF + NU_NSA_B + NU_LRUA + NU_GLAA + NU_CONV;

DEV void mx_unit(const Params& p, int l, int u, unsigned char* lds) {
    if (u < NU_CMP) { cmp_unit(p, l, u, lds); if (PROBE_U == 1) cmp_unit(p, l, u, lds); return; } u -= NU_CMP;
    if (u < NU_NSA_A) { nsa_unit_a(p, l, u, lds); return; } u -= NU_NSA_A;
    if (u < NU_NSA_B) { nsa_unit_b(p, l, u, lds); return; } u -= NU_NSA_B;
    if (u < NU_CONF) { conf_unit(p, l, u, lds); if (PROBE_U == 3) conf_unit(p, l, u, lds); return; } u -= NU_CONF;
    if (u < NU_LRUA) { lru_a_unit(p, l, u, lds); if (PROBE_U == 4) lru_a_unit(p, l, u, lds); return; } u -= NU_LRUA;
    if (u < NU_GLAA) { gla_a_unit(p, l, u, lds); if (PROBE_U == 5) gla_a_unit(p, l, u, lds); return; } u -= NU_GLAA;
    {
        const int tid = opaque_tid(), lane = tid & 63, wid = UNIFORM(tid >> 6); __syncthreads();
        const int it = u * 8 + wid; if (l + 1 < DEPTH && it < IT_LAYER) p0_item(p, (l + 1) * IT_LAYER + it, (float*)lds + wid * (64 * 65), lane); }
}

#ifndef CPU_EMU
namespace pg8 {
#define PG8_LAS __attribute__((address_space(3)))
constexpr int BM = 256, BK = 64, HALF = 128, HTB = HALF * BK * 2, STAGE_BYTES = 8 * HTB, NXCD = 8, WGM = 8;
__host__ __device__ __forceinline__ int lds_byte(int r, int c) { const int st = (r >> 4) * 2 + (c >> 5), rr = r & 15, cc = c & 31, ob = rr * 64 + cc * 2; return st * 1024 + (ob ^ (((ob >> 9) & 1) << 5)); }
__host__ __device__ __forceinline__ void stage_rc(int b, int& R, int& C) { const int st = b / 1024, sb = b % 1024, swz = sb ^ (((sb >> 9) & 1) << 5); R = (st >> 1) * 16 + swz / 64; C = (st & 1) * 32 + (swz % 64) / 2; }
__host__ __device__ __forceinline__ int perm32(int rho) { const int n = rho >> 4, i = rho & 15; return 8 * (i >> 2) + 4 * n + (i & 3); }
struct Unit { int pm, pn; };
struct Gemm { const bf16_t* A; const bf16_t* Bt; int M, N, K; };
struct StaticOrder {
    int nM, nN, nwg, G, c;
    __host__ __device__ void init(int M, int N, int G_, int c_) { nM = M / BM; nN = N / BM; nwg = nM * nN; G = G_; c = c_; }
    __host__ __device__ bool next(int i, Unit& u) const {
        const long L = (long)i * G + c; if (L >= nwg) return false;
        int wgid = (int)L; { const int q = nwg / NXCD, r = nwg % NXCD, xcd = wgid % NXCD, off = wgid / NXCD; wgid = (xcd < r ? xcd * (q + 1) : r * (q + 1) + (xcd - r) * q) + off; }
        const int nig = WGM * nN, gid = wgid / nig, fm = gid * WGM, gsz = (nM - fm) < WGM ? (nM - fm) : WGM;
        u.pm = fm + ((wgid % nig) % gsz); u.pn = (wgid % nig) / gsz; return true;
    }
    __device__ __forceinline__ void a_ready(const Unit&) const {}
    __device__ __forceinline__ void done(const Unit&) const {}
};
struct EpiBf16 {
    static constexpr bool PERM = true, AFTER_DRAIN = false;
    bf16_t* O; int ldc; bf16_t* O2; int pn2;
    const PG8_LAS float* rsc; int rs_stride;
    __device__ __forceinline__ void operator()(const f32x4 (&acc)[2][2][4][2], const Unit& u, int wr, int wc, int fr, int fq, int ui) const {
        const int row0 = u.pm * BM + wr * 64 + fr; const bool red = (unsigned)(u.pn - pn2) < 3u;
        bf16_t* base = red ? O2 + (size_t)(u.pn - pn2) * T * 256 : O; const int ld = red ? 256 : ldc; const int col0 = (red ? 0 : u.pn * BM) + wc * 32 + 8 * fq;
#pragma unroll
        for (int ai = 0; ai < 2; ++ai)
#pragma unroll
            for (int m = 0; m < 4; ++m) { bf16_t* rowp = base + (size_t)(row0 + ai * HALF + m * 16) * ld + col0; const float sc = rsc[ui * rs_stride + ai * HALF + wr * 64 + m * 16 + fr];
#pragma unroll
                for (int bj = 0; bj < 2; ++bj) { const f32x4 v0 = acc[ai][bj][m][0] * sc, v1 = acc[ai][bj][m][1] * sc;
                    u32x4 w; w.x = cvtpk(v0[0], v0[1]); w.y = cvtpk(v0[2], v0[3]); w.z = cvtpk(v1[0], v1[1]); w.w = cvtpk(v1[2], v1[3]);
                    *(u32x4*)(rowp + bj * HALF) = w; } }
    }
};

struct PanelSS {
    float* xsl; unsigned* cnt;
    __device__ __forceinline__ void run(const f32x4 (&v)[2][2][4][2], const Unit& u, int wr, int wc, int fr, int fq, PG8_LAS unsigned char* lds, int wid, int lane) const {
        PG8_LAS float* P = (PG8_LAS float*)lds;
        PG8_LAS float* S = (PG8_LAS float*)(lds + 8192);
#pragma unroll
        for (int ai = 0; ai < 2; ++ai)
#pragma unroll
            for (int m = 0; m < 4; ++m) { float q = 0.f;
#pragma unroll
                for (int bj = 0; bj < 2; ++bj)
#pragma unroll
                    for (int n = 0; n < 2; ++n) { const f32x4 x = v[ai][bj][m][n]; q += (x[0] * x[0] + x[1] * x[1]) + (x[2] * x[2] + x[3] * x[3]); }
                q += __shfl_xor(q, 16); q += __shfl_xor(q, 32);
                if (fq == 0) P[(ai * HALF + wr * 64 + m * 16 + fr) * 4 + wc] = q; }
        asm volatile("s_waitcnt lgkmcnt(0)" ::: "memory"); __builtin_amdgcn_s_barrier(); asm volatile("" ::: "memory");
        const int row = wid * 32 + (lane & 31);
        if (lane < 32) { const float t = (P[row * 4 + 0] + P[row * 4 + 1]) + (P[row * 4 + 2] + P[row * 4 + 3]);
            __hip_atomic_store((unsigned*)xsl + ((size_t)(u.pm * BM + row) * 8 + u.pn), __builtin_bit_cast(unsigned, t), __ATOMIC_RELAXED, __HIP_MEMORY_SCOPE_AGENT); }
        asm volatile("s_waitcnt vmcnt(0)" ::: "memory");
        if (lane == 0) __hip_atomic_fetch_add(cnt + 64 * u.pm, 1u, __ATOMIC_RELAXED, __HIP_MEMORY_SCOPE_AGENT);
        if (wid == 0) { unsigned sp = 0u;
            while ((unsigned)__builtin_amdgcn_readfirstlane(__hip_atomic_load(cnt + 64 * u.pm, __ATOMIC_RELAXED, __HIP_MEMORY_SCOPE_AGENT)) < 64u && ++sp < (1u << 20)) __builtin_amdgcn_s_sleep(2); }
        asm volatile("s_waitcnt vmcnt(0) lgkmcnt(0)" ::: "memory"); __builtin_amdgcn_s_barrier(); asm volatile("" ::: "memory");
        if (lane < 32) { const unsigned* sl = (const unsigned*)xsl + (size_t)(u.pm * BM + row) * 8; float t = 0.f;
#pragma unroll
            for (int j = 0; j < 8; ++j) t += __builtin_bit_cast(float, __hip_atomic_load(sl + j, __ATOMIC_RELAXED, __HIP_MEMORY_SCOPE_AGENT));
            S[row] = __builtin_amdgcn_rsqf(t * (1.0f / 2048.0f) + 1e-6f); }
        asm volatile("s_waitcnt lgkmcnt(0)" ::: "memory"); __builtin_amdgcn_s_barrier(); asm volatile("" ::: "memory");
    }
    __device__ __forceinline__ void publish(const f32x4 (&v)[2][2][4][2], const Unit& u, int wr, int wc, int fr, int fq, PG8_LAS unsigned char* lds, int wid, int lane) const {
        PG8_LAS float* P = (PG8_LAS float*)lds;
#pragma unroll
        for (int ai = 0; ai < 2; ++ai)
#pragma unroll
            for (int m = 0; m < 4; ++m) { float q = 0.f;
#pragma unroll
                for (int bj = 0; bj < 2; ++bj)
#pragma unroll
                    for (int n = 0; n < 2; ++n) { const f32x4 x = v[ai][bj][m][n]; q += (x[0] * x[0] + x[1] * x[1]) + (x[2] * x[2] + x[3] * x[3]); }
                q += __shfl_xor(q, 16); q += __shfl_xor(q, 32);
                if (fq == 0) P[(ai * HALF + wr * 64 + m * 16 + fr) * 4 + wc] = q; }
        asm volatile("s_waitcnt lgkmcnt(0)" ::: "memory"); __builtin_amdgcn_s_barrier(); asm volatile("" ::: "memory");
        const int row = wid * 32 + (lane & 31);
        if (lane < 32) { const float t = (P[row * 4 + 0] + P[row * 4 + 1]) + (P[row * 4 + 2] + P[row * 4 + 3]);
            __hip_atomic_store((unsigned*)xsl + ((size_t)(u.pm * BM + row) * 8 + u.pn), __builtin_bit_cast(unsigned, t), __ATOMIC_RELAXED, __HIP_MEMORY_SCOPE_AGENT); }
    }
};
struct EpiRow {
    static constexpr bool PERM = false, AFTER_DRAIN = true;
    const float* xin_f32; const bf16_t* xin_bf; float* xout_f32; bf16_t* xout_bf; bf16_t* H; const float* post_g; const float* pre_g; PanelSS st1, st2;
    __device__ __forceinline__ void fused(f32x4 (&acc)[2][2][4][2], const Unit& u, int wr, int wc, int fr, int fq, PG8_LAS unsigned char* lds, int wid, int lane) const {
        const PG8_LAS float* S = (const PG8_LAS float*)(lds + 8192);
        const int col0 = u.pn * BM + wc * 32 + 4 * fq;
        u32x2 xw[2][4][2][2];
        {
#pragma unroll
            for (int ai = 0; ai < 2; ++ai)
#pragma unroll
                for (int m = 0; m < 4; ++m) { const size_t off = (size_t)(u.pm * BM + ai * HALF + wr * 64 + m * 16 + fr) * DM + col0;
#pragma unroll
                    for (int bj = 0; bj < 2; ++bj)
#pragma unroll
                        for (int n = 0; n < 2; ++n) xw[ai][m][bj][n] = *(const u32x2*)(xin_bf + off + bj * HALF + n * 16); } }
        f32x4 pg[2][2];
#pragma unroll
        for (int bj = 0; bj < 2; ++bj)
#pragma unroll
            for (int n = 0; n < 2; ++n) pg[bj][n] = *(const f32x4*)(post_g + col0 + bj * HALF + n * 16);
        st1.run(acc, u, wr, wc, fr, fq, lds, wid, lane);
#pragma unroll
        for (int ai = 0; ai < 2; ++ai)
#pragma unroll
            for (int m = 0; m < 4; ++m) { const int r = ai * HALF + wr * 64 + m * 16 + fr; const float rs = S[r]; const size_t off = (size_t)(u.pm * BM + r) * DM + col0;
#pragma unroll
                for (int bj = 0; bj < 2; ++bj)
#pragma unroll
                    for (int n = 0; n < 2; ++n) { f32x4 xo;
                        { const u32x2 w = xw[ai][m][bj][n]; xo = (f32x4){__builtin_bit_cast(float, w.x << 16), __builtin_bit_cast(float, w.x & 0xffff0000u), __builtin_bit_cast(float, w.y << 16), __builtin_bit_cast(float, w.y & 0xffff0000u)}; }
                        const f32x4 xn = xo + acc[ai][bj][m][n] * rs * pg[bj][n]; acc[ai][bj][m][n] = xn;
                        if (xout_f32) *(f32x4*)(xout_f32 + off + bj * HALF + n * 16) = xn;
                        else *(u32x2*)(xout_bf + off + bj * HALF + n * 16) = (u32x2){cvtpk(xn[0], xn[1]), cvtpk(xn[2], xn[3])}; }
                asm volatile("" : "+v"(acc[ai][0][m][0]), "+v"(acc[ai][0][m][1]), "+v"(acc[ai][1][m][0]), "+v"(acc[ai][1][m][1]));
                if (m & 1) asm volatile("" ::: "memory"); }
        if (!H) return;
        st2.publish(acc, u, wr, wc, fr, fq, lds, wid, lane);
    }
};
template <class Epi, class Sched, bool ALIGN_EPI = false, bool SP2 = false>
__device__ __forceinline__ void gemm_phase(PG8_LAS unsigned char* lds, const Gemm g, const Sched& S, const Epi& E) {
    const int tid = opaque_tid(), wid = __builtin_amdgcn_readfirstlane(tid >> 6), lane = tid & 63, wr = wid >> 2, wc = wid & 3, fr = lane & 15, fq = lane >> 4;
    const int K = g.K, nt = K / BK;
    unsigned voffA[2], voffB[2];
#pragma unroll
    for (int i = 0; i < 2; ++i) { int R, C; stage_rc(tid * 16 + i * 8192, R, C); const int Rb = Epi::PERM ? ((R & ~31) + perm32(R & 31)) : R;
        voffA[i] = (unsigned)(R * K + C) * 2u; voffB[i] = (unsigned)(Rb * K + C) * 2u; }
    const size_t kstep = (size_t)(BK * 2);
    const size_t hstep = (size_t)HALF * K * 2;
    const size_t tstep = 2 * hstep;
    const unsigned ldsw = (unsigned)wid * 1024u;
    const int aoff = lds_byte(wr * 64 + fr, fq * 8), boff = lds_byte(wc * 32 + fr, fq * 8);
#define PG8_SA(b, h) (((b) * 2 + (h)) * HTB)
#define PG8_SB(b, h) ((4 + (b) * 2 + (h)) * HTB)
#define PG8_STAGE(bufoff, gbase, voff) do { _Pragma("unroll") for (int _i = 0; _i < 2; ++_i) \
        __builtin_amdgcn_global_load_lds((const unsigned*)((const char*)(gbase) + (voff)[_i]), (PG8_LAS unsigned*)(lds + (bufoff) + ldsw + _i * 8192), 16, 0, 0); } while (0)
#define PG8_LDA(dst, b, h) do { _Pragma("unroll") for (int m = 0; m < 4; ++m) _Pragma("unroll") for (int k = 0; k < 2; ++k) dst[m][k] = *(const PG8_LAS bf16x8*)(lds + PG8_SA(b, h) + aoff + m * 2048 + k * 1024); } while (0)
#define PG8_LDB(dst, b, h) do { _Pragma("unroll") for (int n = 0; n < 2; ++n) _Pragma("unroll") for (int k = 0; k < 2; ++k) dst[n][k] = *(const PG8_LAS bf16x8*)(lds + PG8_SB(b, h) + boff + n * 2048 + k * 1024); } while (0)
#define PG8_MMA(ai, bj, At, Bt) do { __builtin_amdgcn_s_setprio(1); _Pragma("unroll") for (int m = 0; m < 4; ++m) _Pragma("unroll") for (int n = 0; n < 2; ++n) _Pragma("unroll") for (int k = 0; k < 2; ++k) \
        acc[ai][bj][m][n] = __builtin_amdgcn_mfma_f32_16x16x32_bf16(Bt[n][k], At[m][k], acc[ai][bj][m][n], 0, 0, 0); __builtin_amdgcn_s_setprio(0); } while (0)
#define PG8_WAIT_V(n) asm volatile("s_waitcnt vmcnt(" #n ")" ::: "memory")
#define PG8_WAIT_L(n) asm volatile("s_waitcnt lgkmcnt(" #n ")" ::: "memory")
#define PG8_BAR __builtin_amdgcn_s_barrier()
#define PG8_SCHED __builtin_amdgcn_sched_barrier(0)
    Unit cur, nxt; int ui = 0;
    if (!S.next(0, cur)) return;
    f32x4 acc[2][2][4][2];
#pragma unroll
    for (int a = 0; a < 2; ++a)
#pragma unroll
        for (int b = 0; b < 2; ++b)
#pragma unroll
            for (int m = 0; m < 4; ++m)
#pragma unroll
                for (int n = 0; n < 2; ++n) acc[a][b][m][n] = (f32x4){0.f, 0.f, 0.f, 0.f};
    bf16x8 At[4][2], B0[2][2], B1[2][2];
    const char* cA = (const char*)g.A + (size_t)cur.pm * tstep; const char* cB = (const char*)g.Bt + (size_t)cur.pn * tstep;
    S.a_ready(cur);
    if constexpr (SP2) {
        PG8_STAGE(PG8_SB(0, 0), cB, voffB); PG8_STAGE(PG8_SB(0, 1), cB + hstep, voffB); PG8_STAGE(PG8_SA(0, 0), cA, voffA); PG8_STAGE(PG8_SA(0, 1), cA + hstep, voffA);
        if (wr == 1) PG8_BAR;
        PG8_WAIT_V(2); PG8_BAR;
        PG8_STAGE(PG8_SB(1, 0), cB + kstep, voffB); PG8_STAGE(PG8_SA(1, 0), cA + kstep, voffA); PG8_STAGE(PG8_SB(1, 1), cB + hstep + kstep, voffB);
        PG8_WAIT_V(6); PG8_BAR;
    } else {
        PG8_STAGE(PG8_SB(0, 0), cB, voffB); PG8_STAGE(PG8_SA(0, 0), cA, voffA); PG8_STAGE(PG8_SB(0, 1), cB + hstep, voffB); PG8_STAGE(PG8_SA(0, 1), cA + hstep, voffA);
        if (wr == 1) PG8_BAR;
        PG8_WAIT_V(4); PG8_BAR;
        PG8_STAGE(PG8_SB(1, 0), cB + kstep, voffB); PG8_STAGE(PG8_SA(1, 0), cA + kstep, voffA); PG8_STAGE(PG8_SB(1, 1), cB + hstep + kstep, voffB);
        PG8_WAIT_V(6); PG8_BAR;
    }
    for (;;) {
        const bool has_next = S.next(ui + 1, nxt);
        const char* nA = has_next ? (const char*)g.A + (size_t)nxt.pm * tstep : cA; const char* nB = has_next ? (const char*)g.Bt + (size_t)nxt.pn * tstep : cB;
        for (int t = 0; t < nt; t += 2) {
            const bool last = (t == nt - 2);
            const char* a1 = cA + (size_t)(t + 1) * kstep;
            const char* a2 = last ? nA : cA + (size_t)(t + 2) * kstep; const char* b2 = last ? nB : cB + (size_t)(t + 2) * kstep;
            const char* a3 = a2 + kstep; const char* b3 = b2 + kstep;
            if (last && has_next) S.a_ready(nxt);
            if constexpr (SP2) {
            PG8_LDB(B0, 0, 0); PG8_LDB(B1, 0, 1); PG8_SCHED; PG8_LDA(At, 0, 0); PG8_STAGE(PG8_SA(1, 1), a1 + hstep, voffA);
            PG8_WAIT_V(8); PG8_WAIT_L(0); PG8_BAR; PG8_MMA(0, 0, At, B0); PG8_MMA(0, 1, At, B1); PG8_BAR; PG8_SCHED;
            PG8_LDA(At, 0, 1); PG8_STAGE(PG8_SB(0, 0), b2, voffB); PG8_STAGE(PG8_SB(0, 1), b2 + hstep, voffB); PG8_STAGE(PG8_SA(0, 0), a2, voffA);
            PG8_WAIT_V(8); PG8_WAIT_L(0); PG8_BAR; PG8_MMA(1, 0, At, B0); PG8_MMA(1, 1, At, B1); PG8_BAR; PG8_SCHED;
            PG8_LDB(B0, 1, 0); PG8_LDB(B1, 1, 1); PG8_SCHED; PG8_LDA(At, 1, 0); PG8_STAGE(PG8_SA(0, 1), a2 + hstep, voffA);
            PG8_WAIT_V(8); PG8_WAIT_L(0); PG8_BAR; PG8_MMA(0, 0, At, B0); PG8_MMA(0, 1, At, B1); PG8_BAR; PG8_SCHED;
            PG8_LDA(At, 1, 1); PG8_STAGE(PG8_SB(1, 0), b3, voffB); PG8_STAGE(PG8_SB(1, 1), b3 + hstep, voffB); PG8_STAGE(PG8_SA(1, 0), a3, voffA);
            PG8_WAIT_V(8); PG8_WAIT_L(0); PG8_BAR; PG8_MMA(1, 0, At, B0); PG8_MMA(1, 1, At, B1); PG8_BAR; PG8_SCHED;
            } else {
            PG8_LDB(B0, 0, 0); PG8_SCHED; PG8_LDA(At, 0, 0); PG8_STAGE(PG8_SA(1, 1), a1 + hstep, voffA);
            PG8_WAIT_L(8); PG8_BAR; PG8_WAIT_L(0); PG8_MMA(0, 0, At, B0); PG8_BAR; PG8_SCHED;
            PG8_LDB(B1, 0, 1); PG8_STAGE(PG8_SB(0, 0), b2, voffB);
            PG8_BAR; PG8_WAIT_L(0); PG8_MMA(0, 1, At, B1); PG8_BAR;
            PG8_LDA(At, 0, 1); PG8_STAGE(PG8_SA(0, 0), a2, voffA);
            PG8_BAR; PG8_WAIT_L(0); PG8_MMA(1, 0, At, B0); PG8_BAR; PG8_SCHED;
            PG8_STAGE(PG8_SB(0, 1), b2 + hstep, voffB);
            PG8_WAIT_V(6); PG8_BAR; PG8_MMA(1, 1, At, B1); PG8_BAR;
            PG8_LDB(B0, 1, 0); PG8_SCHED; PG8_LDA(At, 1, 0); PG8_STAGE(PG8_SA(0, 1), a2 + hstep, voffA);
            PG8_WAIT_L(8); PG8_BAR; PG8_WAIT_L(0); PG8_MMA(0, 0, At, B0); PG8_BAR; PG8_SCHED;
            PG8_LDB(B1, 1, 1); PG8_STAGE(PG8_SB(1, 0), b3, voffB);
            PG8_BAR; PG8_WAIT_L(0); PG8_MMA(0, 1, At, B1); PG8_BAR;
            PG8_LDA(At, 1, 1); PG8_STAGE(PG8_SA(1, 0), a3, voffA);
            PG8_BAR; PG8_WAIT_L(0); PG8_MMA(1, 0, At, B0); PG8_BAR; PG8_SCHED;
            PG8_STAGE(PG8_SB(1, 1), b3 + hstep, voffB);
            PG8_WAIT_V(6); PG8_BAR; PG8_MMA(1, 1, At, B1); PG8_BAR;
            }
        }
        if constexpr (ALIGN_EPI) { if (wr == 0) PG8_BAR; }
        if constexpr (!Epi::AFTER_DRAIN) { E(acc, cur, wr, wc, fr, fq, ui); S.done(cur); }
        if (!has_next) break;
#pragma unroll
        for (int a = 0; a < 2; ++a)
#pragma unroll
            for (int b = 0; b < 2; ++b)
#pragma unroll
                for (int m = 0; m < 4; ++m)
#pragma unroll
                    for (int n = 0; n < 2; ++n) acc[a][b][m][n] = (f32x4){0.f, 0.f, 0.f, 0.f};
        cur = nxt; cA = nA; cB = nB; ++ui;
        if constexpr (ALIGN_EPI) { if (wr == 1) PG8_BAR; }
    }
    PG8_WAIT_V(0);
    if constexpr (!ALIGN_EPI) { if (wr == 0) PG8_BAR; }
    PG8_BAR;
    if constexpr (Epi::AFTER_DRAIN) { E.fused(acc, cur, wr, wc, fr, fq, lds, wid, lane); S.done(cur); }
#undef PG8_SA
#undef PG8_SB
#undef PG8_STAGE
#undef PG8_LDA
#undef PG8_LDB
#undef PG8_MMA
#undef PG8_WAIT_V
#undef PG8_WAIT_L
#undef PG8_BAR
#undef PG8_SCHED
}
}


#define LAS __attribute__((address_space(3)))
#define XB_TMO      128
#define XB_XCNT(j)  (256  + 64 * (j))
#define XB_XSUB(j)  (1280 + 64 * (j))
#define XB_XGEN(j)  (2304 + 64 * (j))
#define XB_TOP      3328
#define XB_TOPGEN   3392
#define XCD_BAR_WORDS 3456
#define XB_SPIN_CAP (1u << 18)
__device__ __forceinline__ unsigned xb_ld(unsigned* p)              { return __hip_atomic_load(p, __ATOMIC_RELAXED, __HIP_MEMORY_SCOPE_AGENT); }
__device__ __forceinline__ unsigned xb_add(unsigned* p, unsigned v) { return __hip_atomic_fetch_add(p, v, __ATOMIC_RELAXED, __HIP_MEMORY_SCOPE_AGENT); }
__device__ __forceinline__ unsigned xb_xcc_id() { return (unsigned)__builtin_amdgcn_s_getreg((3 << 11) | 20) & 0xFu; }
#define XB_SPIN(cond, bar) do { unsigned _sp = 0; while (cond) { __builtin_amdgcn_s_sleep(1); \
    if ((++_sp & 255u) == 0u) { if (xb_ld(&(bar)[XB_TMO])) break; if (_sp > XB_SPIN_CAP) { atomicAdd(&(bar)[XB_TMO], 1u); break; } } } } while (0)
struct XcdBarrier { unsigned* bar; unsigned x; volatile LAS unsigned* st; };
__device__ __forceinline__ XcdBarrier xcd_barrier_post(unsigned* bar, volatile LAS unsigned* st) {
    XcdBarrier b; b.bar = bar; b.x = xb_xcc_id(); b.st = st;
    if (threadIdx.x == 0) (void)xb_add(&bar[XB_XCNT(b.x)], 1u);
    return b;
}
__device__ __forceinline__ void xcd_barrier_complete(unsigned* bar, unsigned x, unsigned& nloc, unsigned& nx) {
    const unsigned G = gridDim.x * gridDim.y * gridDim.z;
    unsigned sum, cnt, mine, sp = 0u;
    for (;;) {
        sum = 0u; cnt = 0u; mine = 0u;
#pragma unroll
        for (unsigned j = 0; j < 16; ++j) { const unsigned c = xb_ld(&bar[XB_XCNT(j)]); sum += c; cnt += (c > 0u) ? 1u : 0u; mine = (j == x) ? c : mine; }
        if (sum == G) break;
        __builtin_amdgcn_s_sleep(1);
        if ((++sp & 255u) == 0u) { if (xb_ld(&bar[XB_TMO])) break; if (sp > XB_SPIN_CAP) { atomicAdd(&bar[XB_TMO], 1u); break; } }
    }
    nloc = mine > 0u ? mine : 1u; nx = cnt > 0u ? cnt : 1u;
}
__device__ __forceinline__ void xcd_barrier(const XcdBarrier& b) {
    asm volatile("s_waitcnt vmcnt(0)" ::: "memory");
    __syncthreads();
    if (threadIdx.x == 0) {
        unsigned* bar = b.bar;
        __builtin_amdgcn_s_waitcnt(0);
        unsigned nloc = b.st[0], nx = b.st[1];
        if (nloc == 0u) { xcd_barrier_complete(bar, b.x, nloc, nx); b.st[0] = nloc; b.st[1] = nx; }
        const unsigned old = xb_add(&bar[XB_XSUB(b.x)], 1u);
        const unsigned gen = old / nloc;
        if (old + 1u == (gen + 1u) * nloc) {
            __builtin_amdgcn_fence(__ATOMIC_RELEASE, "agent");
            asm volatile("s_waitcnt vmcnt(0)" ::: "memory");
            const unsigned og = xb_add(&bar[XB_TOP], 1u);
            const unsigned tg = og / nx;
            if (og + 1u == (tg + 1u) * nx) xb_add(&bar[XB_TOPGEN], 1u);
            else XB_SPIN(xb_ld(&bar[XB_TOPGEN]) == tg, bar);
            __builtin_amdgcn_fence(__ATOMIC_ACQUIRE, "agent");
            xb_add(&bar[XB_XGEN(b.x)], 1u);
            asm volatile("s_waitcnt vmcnt(0)" ::: "memory");
        } else {
            XB_SPIN(xb_ld(&bar[XB_XGEN(b.x)]) == gen, bar);
            __builtin_amdgcn_fence(__ATOMIC_ACQUIRE, "agent");
            asm volatile("s_waitcnt vmcnt(0)" ::: "memory");
        }
    }
    __syncthreads();
}
constexpr int LDS_DYN = LDS_BYTES - 32;
constexpr size_t WS_CNT = 32768;
#define DYN_LOOP(which, NU, FN) do { unsigned* ctr_ = (unsigned*)(p.ws + WS_CNT) + (size_t)ph * 64; volatile LAS unsigned* slot_ = (volatile LAS unsigned*)((LAS unsigned char*)lds + LDS_DYN); \
        unsigned nxt_ = 0u; if (threadIdx.x == 0) *slot_ = __hip_atomic_fetch_add(ctr_, 1u, __ATOMIC_RELAXED, __HIP_MEMORY_SCOPE_AGENT); __syncthreads(); \
        int u_ = __builtin_amdgcn_readfirstlane((int)*slot_); \
        while (u_ < (NU)) { if (threadIdx.x == 0) nxt_ = __hip_atomic_fetch_add(ctr_, 1u, __ATOMIC_RELAXED, __HIP_MEMORY_SCOPE_AGENT); \
            FN(p, l, u_, lds); __syncthreads(); if (threadIdx.x == 0) *slot_ = nxt_; __syncthreads(); u_ = __builtin_amdgcn_readfirstlane((int)*slot_); } } while (0)
constexpr int LDS_BAR_ST = LDS_BYTES - 16;
constexpr size_t WS_BAR = 4096;

namespace cg = cooperative_groups;
constexpr int NKIND = 6;
constexpr int PH_PER_LAYER = NKIND + ((PROBE_K && PROBE_K <= NKIND) ? 1 : 0), N_PHASES = 1 + (PROBE_K == 8 ? 1 : 0) + PH_PER_LAYER * DEPTH;
__global__ void __launch_bounds__(NTHR, 2) hybrid_fwd(Params p) {
    extern __shared__ __attribute__((aligned(16))) unsigned char lds[];
    const int G = gridDim.x, bx = blockIdx.x;
    volatile LAS unsigned* bst = (volatile LAS unsigned*)((LAS unsigned char*)lds + LDS_BAR_ST);
    if (threadIdx.x == 0) { bst[0] = 0u; bst[1] = 0u; }
    __syncthreads();
    XcdBarrier xb; xb.bar = (unsigned*)(p.ws + WS_BAR); xb.x = 0u; xb.st = bst;
    const bool fused_rp = (G == 256) && (T == 8192);
    if (bx == 0) { const int tid = threadIdx.x; unsigned* bw = (unsigned*)(p.ws + WS_BAR); for (int i = tid; i < XCD_BAR_WORDS; i += NTHR) __hip_atomic_store(bw + i, 0u, __ATOMIC_RELAXED, __HIP_MEMORY_SCOPE_AGENT);
                   unsigned* cw = (unsigned*)(p.ws + WS_CNT); for (int i = tid; i < 40 * 64; i += NTHR) __hip_atomic_store(cw + i, 0u, __ATOMIC_RELAXED, __HIP_MEMORY_SCOPE_AGENT);
                   unsigned* fw = (unsigned*)(p.ws + WS_FLG); for (int i = tid; i < DEPTH * BATCH * 64; i += NTHR) __hip_atomic_store(fw + i, 0u, __ATOMIC_RELAXED, __HIP_MEMORY_SCOPE_AGENT);
                   unsigned* xw = (unsigned*)(p.ws + WS_XCNT); for (int i = tid; i < DEPTH * 2 * 32; i += NTHR) __hip_atomic_store(xw + (size_t)i * 64, 0u, __ATOMIC_RELAXED, __HIP_MEMORY_SCOPE_AGENT);
                   unsigned* cc = (unsigned*)(p.ws + WS_CCNT); for (int i = tid; i < DEPTH * 2 * BATCH * 9; i += NTHR) __hip_atomic_store(cc + i, 0u, __ATOMIC_RELAXED, __HIP_MEMORY_SCOPE_AGENT);
                   unsigned* nw = (unsigned*)(p.ws + WS_NCNT); for (int i = tid; i < DEPTH * BATCH * 32; i += NTHR) __hip_atomic_store(nw + i, 0u, __ATOMIC_RELAXED, __HIP_MEMORY_SCOPE_AGENT); }
    cg::this_grid().sync(); xb = xcd_barrier_post((unsigned*)(p.ws + WS_BAR), bst);
    for (int ph = p.ph_lo; ph < p.ph_hi; ++ph) {
        const int tid = opaque_tid(), lane = tid & 63, wave = UNIFORM(tid >> 6);
        if (ph == 0 || (PROBE_K == 8 && ph == 1)) {
            float* scr = (float*)lds + wave * (64 * 65);
            const int gw = bx * 8 + wave, NGW = G * 8;
            p0_copy_params(p, bx * NTHR + tid, G * NTHR);
            for (int it = gw; it < IT_LAYER; it += NGW) p0_item(p, it, scr, lane);
            for (int m = gw; m < T; m += NGW) rowpass_row(p, 0, m, lane, fused_rp);
        } else {
            const int ph1 = ph - 1 - (PROBE_K == 8 ? 1 : 0); const int l = ph1 / PH_PER_LAYER; int k = ph1 % PH_PER_LAYER;
            if (PROBE_K && PROBE_K <= NKIND && k >= PROBE_K) --k;
            if (k == 0) {
                const bool xdirect = fused_rp;
                PG8_LAS float* rsc = (PG8_LAS float*)((PG8_LAS unsigned char*)lds + 131072);
                pg8::StaticOrder S; S.init(T, NP, G, bx);
                if (xdirect) { const float* sl = (const float*)(p.ws + WS_XSL) + (size_t)(l >= 1 ? (l - 1) * 2 + 1 : DEPTH * 2) * T * 8;
#pragma unroll
                    for (int i = 0; i < 3; ++i) { pg8::Unit uu; if (S.next(i, uu) && tid < 256) { const f32x4* q = (const f32x4*)(sl + (size_t)(uu.pm * 256 + tid) * 8); const f32x4 a = q[0], b = q[1];
                        rsc[i * 256 + tid] = __builtin_amdgcn_rsqf((((a[0] + a[1]) + (a[2] + a[3])) + ((b[0] + b[1]) + (b[2] + b[3]))) * (1.0f / 2048.0f) + 1e-6f); } }
                } else if (tid < 256) rsc[tid] = 1.0f;
                __syncthreads();
                pg8::Gemm g{(xdirect && l >= 1) ? (const bf16_t*)(p.ws + ((l & 1) ? WS_XA : WS_XB)) : (const bf16_t*)(p.ws + WS_H), (const bf16_t*)(p.ws + WS_WIN) + (size_t)l * NP * DM, T, NP, DM};
                pg8::EpiBf16 E{(bf16_t*)(p.ws + WS_PROJ), NP, (bf16_t*)(p.ws + WS_KVC), C_KC / 256, rsc, xdirect ? 256 : 0};
                pg8::gemm_phase<pg8::EpiBf16, pg8::StaticOrder, true, true>((PG8_LAS unsigned char*)lds, g, S, E);
            } else if (k == 1) {
                DYN_LOOP(0, NU_MX, mx_unit);
            } else if (k == 2) {
                gla_scan(p, bx * NTHR + tid, G * NTHR); lru_scan(p, (G - 1 - bx) * NTHR + tid, G * NTHR);
            } else if (k == 3) {
                const int gw = bx * 8 + wave, NGW = G * 8; float* tile = (float*)lds + wave * 2048;
                for (int wu = gw; wu < NW_GLAC; wu += NGW) gla_c_wave(p, l, wu, lane, tile);
                for (int wu = gw; wu < NW_LRUB; wu += NGW) lru_b_wave(p, l, wu, lane);
            } else if (k == 4) {
                pg8::Gemm g{(const bf16_t*)(p.ws + WS_MIXED), (const bf16_t*)(p.ws + WS_WOUT) + (size_t)l * DM * DM, T, DM, DM};
                pg8::StaticOrder S; S.init(T, DM, G, bx);
                if (fused_rp) {
                    const int l1 = l + 1; const bool last = (l1 == DEPTH);
                    float* xs = (float*)(p.ws + WS_XSL) + (size_t)(l * 2) * T * 8; unsigned* xc = (unsigned*)(p.ws + WS_XCNT) + (size_t)(l * 2) * 32 * 64;
                    pg8::EpiRow E{nullptr, l1 <= 1 ? (const bf16_t*)(p.ws + WS_H) : (const bf16_t*)(p.ws + ((l1 & 1) ? WS_XB : WS_XA)), last ? p.out : nullptr, last ? nullptr : (bf16_t*)(p.ws + ((l1 & 1) ? WS_XA : WS_XB)),
                                  last ? nullptr : (bf16_t*)(p.ws + WS_H), PARF(p, PO_POST_G) + (size_t)l * DM, last ? nullptr : PARF(p, PO_PRE_G) + (size_t)l1 * DM,
                                  pg8::PanelSS{xs, xc}, pg8::PanelSS{xs + (size_t)T * 8, xc + 32 * 64}};
                    pg8::gemm_phase<pg8::EpiRow, pg8::StaticOrder, false, true>((PG8_LAS unsigned char*)lds, g, S, E);
                } else { PG8_LAS float* rsc = (PG8_LAS float*)((PG8_LAS unsigned char*)lds + 131072); if (tid < 256) rsc[tid] = 1.0f; __syncthreads();
                    pg8::EpiBf16 E{(bf16_t*)(p.ws + WS_Y), DM, (bf16_t*)(p.ws + WS_Y), 4096, rsc, 0};
                    pg8::gemm_phase<pg8::EpiBf16, pg8::StaticOrder, true, true>((PG8_LAS unsigned char*)lds, g, S, E); }
            } else if (!fused_rp) {
                const int gw = bx * 8 + wave, NGW = G * 8;
                for (int m = gw; m < T; m += NGW) rowpass_row(p, l + 1, m, lane);
            }
        }
        if (fused_rp && ph > 0 && ((ph - 1 - (PROBE_K == 8 ? 1 : 0)) % PH_PER_LAYER) == PH_PER_LAYER - 1) continue;
        if (ph + 1 < p.ph_hi) {
            xcd_barrier(xb);
        }
    }
}

#ifndef N_LAUNCH_MODE
#define N_LAUNCH_MODE 0
#endif
extern "C" void kernel_launch(void* const* d_in, const int* in_sizes, int n_in, void* d_out, int out_size, void* d_ws, size_t ws_size, hipStream_t stream) {
    static int grid = 0;
    if (grid == 0) {
        if (n_in != N_IN || out_size != T * DM || ws_size < WS_END) { fprintf(stderr, "kernel_launch: unexpected shapes (n_in %d out %d ws %zu need %zu)\n", n_in, out_size, ws_size, (size_t)WS_END); grid = -1; return; }
        int dev = 0, cus = 0, per_cu = 0;
        (void)hipGetDevice(&dev); (void)hipDeviceGetAttribute(&cus, hipDeviceAttributeMultiprocessorCount, dev);
        if (hipFuncSetAttribute((const void*)hybrid_fwd, hipFuncAttributeMaxDynamicSharedMemorySize, LDS_BYTES) != hipSuccess) { fprintf(stderr, "kernel_launch: hipFuncSetAttribute failed\n"); grid = -1; return; }
        if (hipOccupancyMaxActiveBlocksPerMultiprocessor(&per_cu, (const void*)hybrid_fwd, NTHR, LDS_BYTES) != hipSuccess || per_cu < 1) { fprintf(stderr, "kernel_launch: occupancy query says %d\n", per_cu); per_cu = 1; }
        (void)hipGetLastError();
        grid = cus * 1;
        if (grid <= 0) grid = 256;
    }
    if (grid < 0) return;
    Params p{};
    for (int i = 0; i < N_IN; ++i) p.in[i] = (const float*)d_in[i];
    p.out = (float*)d_out; p.ws = (unsigned char*)d_ws;
#if N_LAUNCH_MODE == 0
    p.ph_lo = 0; p.ph_hi = N_PHASES;
    { void* args[] = {&p}; hipError_t e = hipLaunchCooperativeKernel((const void*)hybrid_fwd, dim3(grid), dim3(NTHR), args, LDS_BYTES, stream);
      if (e != hipSuccess) fprintf(stderr, "cooperative launch failed: %s (grid %d)\n", hipGetErrorString(e), grid); }
#else
    for (int ph = 0; ph < N_PHASES; ++ph) { p.ph_lo = ph; p.ph_hi = ph + 1; void* args[] = {&p};
        hipError_t e = hipLaunchCooperativeKernel((const void*)hybrid_fwd, dim3(grid), dim3(NTHR), args, LDS_BYTES, stream);
        if (e != hipSuccess) { fprintf(stderr, "launch %d failed: %s\n", ph, hipGetErrorString(e)); break; } }
#endif
}
#endif
```

```cpp
#ifdef CPU_EMU
#include "hipemu.h"
#else
#include <hip/hip_runtime.h>
#include <hip/hip_cooperative_groups.h>
#include <cstdio>
#include <cstdint>
typedef short bf16x8 __attribute__((ext_vector_type(8)));
typedef short s16x4 __attribute__((ext_vector_type(4)));
typedef float f32x16 __attribute__((ext_vector_type(16)));
typedef float f32x4 __attribute__((ext_vector_type(4)));
typedef float f32x2 __attribute__((ext_vector_type(2)));
typedef unsigned u32x4 __attribute__((ext_vector_type(4)));
typedef unsigned u32x2 __attribute__((ext_vector_type(2)));
#endif
#include <cmath>

#ifndef PROBE_K
#define PROBE_K 0
#endif
#ifndef PROBE_U
#define PROBE_U 0
#endif
#ifndef PROBE_C
#define PROBE_C 0
#endif
#ifndef BATCH
#define BATCH 4
#endif
#ifndef DEPTH
#define DEPTH 4
#endif
#define DEV __device__ __forceinline__
typedef unsigned short bf16_t;

#ifdef CPU_EMU
#define MFMA32(a, b, c) emu_mfma32(a, b, c)
#define MFMA16(a, b, c) emu_mfma16(a, b, c)
#define SHFLX(v, m) emu_shfl_xor(v, m)
#define SHFLXU(v, m) emu_shfl_xor_u(v, m)
#define SHFL(v, s) emu_shfl(v, s)
#define PLSWAP(a, b) emu_permlane32_swap(a, b)
#define ANY(p) emu_any(p)
#define ALL(p) emu_all(p)
#define EXP2F(x) exp2f(x)
#define EXPF(x) expf(x)
#define LOGF(x) logf(x)
#define RCPF(x) (1.0f / (x))
#define RSQF(x) (1.0f / sqrtf(x))
#define LDS_ADDR(p) ((unsigned)((const unsigned char*)(p) - emu::lds_mem))
#define TRREAD(dst, base, off) dst = emu_ds_read_tr16((unsigned)((base) + (off)))
#define WAVE_SYNC() (void)emu_any(false)
#define LGKM0()
#define SBAR()
#define UNIFORM(x) (x)
#define LAUNDER(p)
#define GLDS16(src, ldsdst) memcpy((unsigned char*)(ldsdst) + (threadIdx.x & 63) * 16, (const void*)(src), 16)
#define DMA_WAIT()
static inline unsigned cvtpk(float lo, float hi) { return (unsigned)emu::f2bf(lo) | ((unsigned)emu::f2bf(hi) << 16); }
#else
#define MFMA32(a, b, c) __builtin_amdgcn_mfma_f32_32x32x16_bf16(a, b, c, 0, 0, 0)
#define MFMA16(a, b, c) __builtin_amdgcn_mfma_f32_16x16x32_bf16(a, b, c, 0, 0, 0)
#define SHFLX(v, m) __shfl_xor(v, m)
#define SHFLXU(v, m) ((unsigned)__shfl_xor((int)(v), m))
#define SHFL(v, s) __shfl(v, s)
#define PLSWAP(a, b) __builtin_amdgcn_permlane32_swap(a, b, false, false)
#define ANY(p) __any(p)
#define ALL(p) __all(p)
#define EXP2F(x) __builtin_amdgcn_exp2f(x)
#define EXPF(x) __expf(x)
#define LOGF(x) __logf(x)
#define RCPF(x) __builtin_amdgcn_rcpf(x)
#define RSQF(x) __builtin_amdgcn_rsqf(x)
#define LDS_ADDR(p) ((unsigned)(uintptr_t)(p))
#define TRREAD(dst, base, off) asm volatile("ds_read_b64_tr_b16 %0, %1 offset:%2" : "=&v"(dst) : "v"(base), "i"(off) : "memory")
#define WAVE_SYNC() asm volatile("s_waitcnt lgkmcnt(0)" ::: "memory")
#define LGKM0() asm volatile("s_waitcnt lgkmcnt(0)" ::: "memory")
#define SBAR() __builtin_amdgcn_sched_barrier(0)
#define UNIFORM(x) __builtin_amdgcn_readfirstlane(x)
#define LAUNDER(p) asm volatile("" : "+v"(p))
#define GLDS16(src, ldsdst) __builtin_amdgcn_global_load_lds((const unsigned*)(src), (__attribute__((address_space(3))) unsigned*)(ldsdst), 16, 0, 0)
#define DMA_WAIT() asm volatile("s_waitcnt vmcnt(0)" ::: "memory")
DEV unsigned cvtpk(float lo, float hi) { unsigned r; asm volatile("v_cvt_pk_bf16_f32 %0, %1, %2" : "=v"(r) : "v"(lo), "v"(hi)); return r; }
#endif

#ifdef CPU_EMU
static inline int opaque_tid() { return (int)threadIdx.x; }
#else
DEV int opaque_tid() { int t = threadIdx.x; asm volatile("" : "+v"(t)); return t; }
#endif
DEV unsigned f_as_u(float f) { return __builtin_bit_cast(unsigned, f); }
DEV float u_as_f(unsigned u) { return __builtin_bit_cast(float, u); }
DEV bf16_t f2bf(float f) { unsigned u = f_as_u(f); return (bf16_t)((u + 0x7fffu + ((u >> 16) & 1u)) >> 16); }
DEV float bf2f(bf16_t h) { return u_as_f((unsigned)h << 16); }
DEV unsigned pk2(float lo, float hi) { return (unsigned)f2bf(lo) | ((unsigned)f2bf(hi) << 16); }
DEV float wave_sum(float v) {
#pragma unroll
    for (int o = 1; o < 64; o <<= 1) v += SHFLX(v, o);
    return v;
}
DEV float sigm(float x) { return RCPF(1.0f + EXPF(-x)); }
DEV float siluf(float x) { return x * sigm(x); }
DEV bf16x8 pack8(f32x4 a, f32x4 b) { u32x4 w = {cvtpk(a[0], a[1]), cvtpk(a[2], a[3]), cvtpk(b[0], b[1]), cvtpk(b[2], b[3])}; return __builtin_bit_cast(bf16x8, w); }

constexpr int SEQ = 2048, T = BATCH * SEQ, DM = 2048, NP = 6144, DPROJ = 5916, NTHR = 512;
constexpr float EPS = 1e-6f;
constexpr int C_GQ = 0, C_GK = 256, C_GV = 512, C_GZ = 1024, C_LX = 1536, C_LZ = 2048, C_NQ = 2560, C_KC = 3072, C_VC = 3200, C_KS = 3328,
              C_VS = 3456, C_KW = 3584, C_VW = 3712, C_NZ = 3840, C_CV = 4352, C_CG = 4864, C_CZ = 5376, C_FG = 5888, C_NG = 5904;
__host__ __device__ inline int win_src_col(int n) {
    if (n < 1024) return n;
    if (n < 3840) return n + 16;
    if (n < 5888) return n + 28;
    if (n < 5904) return n - 5888 + 1024;
    if (n < 5916) return n - 5904 + 3856;
    return -1;
}
enum { I_X = 0, I_PRE_G, I_W_IN, I_FG2_W, I_FG2_B, I_LCONV_W, I_LCONV_B, I_LWA, I_LBA, I_LWX, I_LBX, I_LLAM, I_POSK, I_W1K, I_W2K, I_POSV, I_W1V, I_W2V,
       I_DW_W, I_DW_B, I_LN_G, I_LN_B, I_PW_W, I_PW_B, I_BR_G, I_W_OUT, I_POST_G, N_IN };
constexpr size_t MiB = 1u << 20;
constexpr size_t al(size_t x) { return (x + MiB - 1) / MiB * MiB; }
constexpr size_t WS_CTL = 0;
constexpr size_t WS_PAR = 65536;
constexpr size_t WS_WIN = 1 * MiB;
constexpr size_t WS_WOUT = WS_WIN + al((size_t)DEPTH * NP * DM * 2);
constexpr size_t WS_PW = WS_WOUT + al((size_t)DEPTH * DM * DM * 2);
constexpr size_t WS_W1 = WS_PW + al((size_t)DEPTH * 512 * 512 * 2);
constexpr size_t WS_W2 = WS_W1 + al((size_t)DEPTH * 2 * 128 * 4096 * 2);
constexpr size_t WS_LRU = WS_W2 + al((size_t)DEPTH * 2 * 128 * 128 * 2);
constexpr size_t WS_H = WS_LRU + al((size_t)DEPTH * 8 * 128 * 128 * 2);
constexpr size_t WS_PROJ = WS_H + al((size_t)T * DM * 2);
constexpr size_t WS_MIXED = WS_PROJ + al((size_t)T * NP * 2);
constexpr size_t WS_Y = WS_MIXED + al((size_t)T * DM * 2);
constexpr size_t WS_KCMP = WS_Y + al((size_t)T * DM * 2);
constexpr size_t WS_GOI = WS_KCMP + al((size_t)2 * BATCH * 128 * 128 * 2);
constexpr size_t WS_GDS = WS_GOI + al((size_t)BATCH * 128 * 64 * 128 * 4);
constexpr size_t WS_GQD = WS_GDS + al((size_t)BATCH * 128 * 64 * 128 * 4);
constexpr size_t WS_GDEC = WS_GQD + al((size_t)BATCH * 128 * 64 * 64 * 2);
constexpr size_t WS_GST = WS_GDEC + al((size_t)BATCH * 128 * 64 * 4);
constexpr size_t WS_LH = WS_GST + al((size_t)BATCH * 128 * 8192 * 2);
constexpr size_t WS_LP = WS_LH + al((size_t)T * 512 * 4);
constexpr size_t WS_LCAR = WS_LP + al((size_t)T * 512 * 4);
constexpr size_t WS_NACC = WS_LCAR + al((size_t)BATCH * 32 * 512 * 4);
constexpr size_t WS_NSLC = WS_NACC + al((size_t)BATCH * 96 * 256 * 128 * 4);
constexpr size_t WS_NML = WS_NSLC + al((size_t)BATCH * 96 * 256 * 128 * 4);
constexpr size_t WS_XA = WS_NML + al((size_t)BATCH * 96 * 256 * 2 * 4);
constexpr size_t WS_XB = WS_XA + al((size_t)T * DM * 4);
constexpr size_t WS_KVC = WS_XB + al((size_t)T * DM * 4);
constexpr size_t WS_CPART = WS_KVC + al((size_t)3 * T * 256 * 2);
constexpr size_t WS_XSL = WS_CPART + al((size_t)2 * BATCH * 9 * 4 * 2048 * 4);
constexpr size_t WS_END = WS_XSL + al((size_t)(DEPTH * 2 + 1) * T * 8 * 4);
constexpr size_t WS_XCNT = 819200;
constexpr size_t WS_CCNT = 57344;
constexpr size_t WS_NCNT = 53248;
constexpr int LDS_BYTES = 144 * 1024;

struct ParSeg { int idx, per_layer, off; };
constexpr int PO_PRE_G = 0, PO_FG2_W = PO_PRE_G + DEPTH * 2048, PO_FG2_B = PO_FG2_W + DEPTH * 4096, PO_LCONV_W = PO_FG2_B + DEPTH * 256, PO_LCONV_B = PO_LCONV_W + DEPTH * 2048,
              PO_LBA = PO_LCONV_B + DEPTH * 512, PO_LBX = PO_LBA + DEPTH * 512, PO_LLAM = PO_LBX + DEPTH * 512, PO_POSK = PO_LLAM + DEPTH * 512, PO_POSV = PO_POSK + DEPTH * 4096,
              PO_DW_W = PO_POSV + DEPTH * 4096, PO_DW_B = PO_DW_W + DEPTH * 31 * 512, PO_LN_G = PO_DW_B + DEPTH * 512, PO_LN_B = PO_LN_G + DEPTH * 512, PO_PW_B = PO_LN_B + DEPTH * 512,
              PO_BR_G = PO_PW_B + DEPTH * 512, PO_POST_G = PO_BR_G + DEPTH * 2048, PO_END = PO_POST_G + DEPTH * 2048;
constexpr int N_PARSEG = 17;
__device__ const ParSeg PARSEG[N_PARSEG] = {{I_PRE_G, 2048, PO_PRE_G}, {I_FG2_W, 4096, PO_FG2_W}, {I_FG2_B, 256, PO_FG2_B}, {I_LCONV_W, 2048, PO_LCONV_W}, {I_LCONV_B, 512, PO_LCONV_B},
    {I_LBA, 512, PO_LBA}, {I_LBX, 512, PO_LBX}, {I_LLAM, 512, PO_LLAM}, {I_POSK, 4096, PO_POSK}, {I_POSV, 4096, PO_POSV}, {I_DW_W, 31 * 512, PO_DW_W}, {I_DW_B, 512, PO_DW_B},
    {I_LN_G, 512, PO_LN_G}, {I_LN_B, 512, PO_LN_B}, {I_PW_B, 512, PO_PW_B}, {I_BR_G, 2048, PO_BR_G}, {I_POST_G, 2048, PO_POST_G}};
static_assert(WS_PAR + (size_t)PO_END * 4 <= 1 * MiB, "parameter region");
struct Params {
    const float* in[N_IN];
    float* out;
    unsigned char* ws;
    int ph_lo, ph_hi;
};
DEV const bf16_t* PROJp(const Params& p) { return (const bf16_t*)(p.ws + WS_PROJ); }
DEV const float* PARF(const Params& p, int off) { return (const float*)(p.ws + WS_PAR) + off; }

DEV void transpose_item(const float* src, int K, int Nsrc, bf16_t* dst, int k0, int n0, bool winmap, float* scr, int lane, const float* kscale = nullptr) {
    const int np = n0 + 4 * (lane & 15); const int sc = winmap ? win_src_col(np) : np; const int scc = sc >= 0 ? sc : 0; const float mk = (float)(sc >= 0);
    f32x4 v[16];
#pragma unroll
    for (int i = 0; i < 16; ++i) v[i] = *(const f32x4*)(src + (size_t)(k0 + 4 * i + (lane >> 4)) * Nsrc + scc);
#pragma unroll
    for (int i = 0; i < 16; ++i) { float* d = scr + (4 * i + (lane >> 4)) * 65 + 4 * (lane & 15); const float mi = kscale ? mk * kscale[k0 + 4 * i + (lane >> 4)] : mk; d[0] = v[i][0] * mi; d[1] = v[i][1] * mi; d[2] = v[i][2] * mi; d[3] = v[i][3] * mi; }
    WAVE_SYNC();
    const int c = lane & 7;
#pragma unroll
    for (int j = 0; j < 8; ++j) { const int n = (lane >> 3) + 8 * j; const float* s_ = scr + (8 * c) * 65 + n;
        u32x4 o; o.x = pk2(s_[0 * 65], s_[1 * 65]); o.y = pk2(s_[2 * 65], s_[3 * 65]); o.z = pk2(s_[4 * 65], s_[5 * 65]); o.w = pk2(s_[6 * 65], s_[7 * 65]);
        *(u32x4*)(dst + (size_t)(n0 + n) * K + k0 + 8 * c) = o; }
    WAVE_SYNC();
}
constexpr int IT_WIN = (DM / 64) * (NP / 64), IT_WOUT = (DM / 64) * (DM / 64), IT_PW = (512 / 64) * (512 / 64), IT_W1 = (4096 / 64) * (128 / 64),
              IT_W2 = (128 / 64) * (128 / 64), IT_LRU = (128 / 64) * (128 / 64);
constexpr int IT_LAYER = IT_WIN + IT_WOUT + IT_PW + 2 * IT_W1 + 2 * IT_W2 + 8 * IT_LRU;
DEV void p0_item(const Params& p, int it, float* scr, int lane) {
    const int l = it / IT_LAYER; int r = it % IT_LAYER;
    unsigned char* ws = p.ws;
    if (r < IT_WIN) { const int nb = NP / 64;
        transpose_item(p.in[I_W_IN] + (size_t)l * DM * DPROJ, DM, DPROJ, (bf16_t*)(ws + WS_WIN) + (size_t)l * NP * DM, 64 * (r / nb), 64 * (r % nb), true, scr, lane, p.in[I_PRE_G] + (size_t)l * DM); return; }
    r -= IT_WIN;
    if (r < IT_WOUT) { const int nb = DM / 64; transpose_item(p.in[I_W_OUT] + (size_t)l * DM * DM, DM, DM, (bf16_t*)(ws + WS_WOUT) + (size_t)l * DM * DM, 64 * (r / nb), 64 * (r % nb), false, scr, lane); return; }
    r -= IT_WOUT;
    if (r < IT_PW) { const int nb = 512 / 64; transpose_item(p.in[I_PW_W] + (size_t)l * 512 * 512, 512, 512, (bf16_t*)(ws + WS_PW) + (size_t)l * 512 * 512, 64 * (r / nb), 64 * (r % nb), false, scr, lane); return; }
    r -= IT_PW;
    if (r < 2 * IT_W1) { const int kv = r / IT_W1; r %= IT_W1; const int nb = 128 / 64;
        transpose_item(p.in[kv ? I_W1V : I_W1K] + (size_t)l * 4096 * 128, 4096, 128, (bf16_t*)(ws + WS_W1) + (size_t)(l * 2 + kv) * 128 * 4096, 64 * (r / nb), 64 * (r % nb), false, scr, lane); return; }
    r -= 2 * IT_W1;
    if (r < 2 * IT_W2) { const int kv = r / IT_W2; r %= IT_W2; const int nb = 128 / 64;
        transpose_item(p.in[kv ? I_W2V : I_W2K] + (size_t)l * 128 * 128, 128, 128, (bf16_t*)(ws + WS_W2) + (size_t)(l * 2 + kv) * 128 * 128, 64 * (r / nb), 64 * (r % nb), false, scr, lane); return; }
    r -= 2 * IT_W2;
    { const int m = r / IT_LRU; r %= IT_LRU; const int hh = m >> 1, ax = m & 1; const int nb = 128 / 64;
        transpose_item(p.in[ax ? I_LWX : I_LWA] + (size_t)(l * 4 + hh) * 128 * 128, 128, 128, (bf16_t*)(ws + WS_LRU) + (size_t)((l * 4 + hh) * 2 + ax) * 128 * 128, 64 * (r / nb), 64 * (r % nb), false, scr, lane); }
}

DEV void p0_copy_params(const Params& p, int gtid, int gstride) {
    float* dst = (float*)(p.ws + WS_PAR);
#pragma unroll 1
    for (int s = 0; s < N_PARSEG; ++s) { const ParSeg sg = PARSEG[s]; const float* src = p.in[sg.idx]; const int n = sg.per_layer * DEPTH;
        for (int i = gtid; i < n; i += gstride) dst[sg.off + i] = src[i]; }
}

DEV void rowpass_row(const Params& p, int l, int m, int lane, bool direct0 = false) {
    f32x4 v[8];
    if (l <= 1) { const f32x4* xr = (const f32x4*)(p.in[I_X] + (size_t)m * DM) + lane;
#pragma unroll
        for (int j = 0; j < 8; ++j) v[j] = xr[64 * j]; }
    else { const u32x2* xr = (const u32x2*)((const bf16_t*)(p.ws + ((l & 1) ? WS_XB : WS_XA)) + (size_t)m * DM) + lane;
#pragma unroll
        for (int j = 0; j < 8; ++j) { const u32x2 w = xr[64 * j]; v[j] = (f32x4){u_as_f(w.x << 16), u_as_f(w.x & 0xffff0000u), u_as_f(w.y << 16), u_as_f(w.y & 0xffff0000u)}; } }
    if (l >= 1) {
        const u32x2* yr = (const u32x2*)((const bf16_t*)(p.ws + WS_Y) + (size_t)m * DM) + lane; f32x4 y[8]; float s = 0.f;
#pragma unroll
        for (int j = 0; j < 8; ++j) { const u32x2 w = yr[64 * j]; y[j] = (f32x4){u_as_f(w.x << 16), u_as_f(w.x & 0xffff0000u), u_as_f(w.y << 16), u_as_f(w.y & 0xffff0000u)};
            s += (y[j][0] * y[j][0] + y[j][1] * y[j][1]) + (y[j][2] * y[j][2] + y[j][3] * y[j][3]); }
        const float rs = RSQF(wave_sum(s) * (1.0f / DM) + EPS);
        const f32x4* g = (const f32x4*)(PARF(p, PO_POST_G) + (size_t)(l - 1) * DM) + lane;
#pragma unroll
        for (int j = 0; j < 8; ++j) v[j] = v[j] + y[j] * rs * g[64 * j];
        if (l == DEPTH) { f32x4* o = (f32x4*)(p.out + (size_t)m * DM) + lane;
#pragma unroll
            for (int j = 0; j < 8; ++j) o[64 * j] = v[j]; }
        else { u32x2* o = (u32x2*)((bf16_t*)(p.ws + ((l & 1) ? WS_XA : WS_XB)) + (size_t)m * DM) + lane;
#pragma unroll
            for (int j = 0; j < 8; ++j) o[64 * j] = (u32x2){pk2(v[j][0], v[j][1]), pk2(v[j][2], v[j][3])}; }
    }
    if (l < DEPTH) {
        float s = 0.f;
#pragma unroll
        for (int j = 0; j < 8; ++j) s += (v[j][0] * v[j][0] + v[j][1] * v[j][1]) + (v[j][2] * v[j][2] + v[j][3] * v[j][3]);
        const float wave_ss = wave_sum(s); const float rs = RSQF(wave_ss * (1.0f / DM) + EPS);
        u32x2* h = (u32x2*)((bf16_t*)(p.ws + WS_H) + (size_t)m * DM) + lane;
#pragma unroll
        for (int j = 0; j < 8; ++j) { const f32x4 t = direct0 ? v[j] : v[j] * rs; h[64 * j] = (u32x2){pk2(t[0], t[1]), pk2(t[2], t[3])}; }
        if (direct0 && lane == 0) { f32x4* sl = (f32x4*)((float*)(p.ws + WS_XSL) + (size_t)(DEPTH * 2) * T * 8 + (size_t)m * 8); sl[0] = (f32x4){wave_ss, 0.f, 0.f, 0.f}; sl[1] = (f32x4){0.f, 0.f, 0.f, 0.f}; }
    }
}

template <int NR> DEV void finalize_core(const Params& p, const f32x2 (&v)[NR], const unsigned (&zz)[NR], f32x2 g, int tok0, int mixcol, int lane) {
    float ss[NR];
#pragma unroll
    for (int r = 0; r < NR; ++r) ss[r] = v[r][0] * v[r][0] + v[r][1] * v[r][1];
#pragma unroll
    for (int o = 1; o < 64; o <<= 1)
#pragma unroll
        for (int r = 0; r < NR; ++r) ss[r] += SHFLX(ss[r], o);
#pragma unroll
    for (int r = 0; r < NR; ++r) { const float sc = RSQF(ss[r] * (1.0f / 128.0f) + EPS);
        const float z0 = u_as_f(zz[r] << 16), z1 = u_as_f(zz[r] & 0xffff0000u);
        *(unsigned*)((bf16_t*)(p.ws + WS_MIXED) + (size_t)(tok0 + r) * DM + mixcol + 2 * lane) = pk2(v[r][0] * sc * g[0] * siluf(z0), v[r][1] * sc * g[1] * siluf(z1)); }
}
template <int NR> DEV void load_zg(const Params& p, int l, unsigned (&zz)[NR], f32x2& g, int tok0, int mixcol, int zcol, int lane) {
    g = *(const f32x2*)(PARF(p, PO_BR_G) + (size_t)l * DM + mixcol + 2 * lane);
#pragma unroll
    for (int r = 0; r < NR; ++r) zz[r] = *(const unsigned*)(PROJp(p) + (size_t)(tok0 + r) * NP + zcol + 2 * lane);
}
template <int NR> DEV void finalize_vals(const Params& p, int l, const f32x2 (&v)[NR], int tok0, int mixcol, int zcol, int lane) {
    unsigned zz[NR]; f32x2 g; load_zg<NR>(p, l, zz, g, tok0, mixcol, zcol, lane); finalize_core<NR>(p, v, zz, g, tok0, mixcol, lane);
}
template <int NR> DEV void finalize_rows(const Params& p, int l, const float* rowp, int ld, int tok0, int mixcol, int zcol, int lane) {
    f32x2 v[NR];
#pragma unroll
    for (int r = 0; r < NR; ++r) v[r] = *(const f32x2*)(rowp + (size_t)r * ld + 2 * lane);
    finalize_vals<NR>(p, l, v, tok0, mixcol, zcol, lane);
}

DEV void conf_unit(const Params& p, int l, int u, unsigned char* lds) {
    const int tid = opaque_tid(), lane = tid & 63, wid = UNIFORM(tid >> 6);
    const int b = u >> 6, t0 = 32 * (u & 63), tb = b * SEQ;
    constexpr int LD = 516, YLD = 520;
    bf16_t* Y = (bf16_t*)lds;
    float* cv = (float*)(lds + 65536);
    const bf16_t* PR = PROJp(p);
    float w[31];
#pragma unroll
    for (int k = 0; k < 31; ++k) w[k] = PARF(p, PO_DW_W)[(size_t)(l * 31 + k) * 512 + tid];
    const float bias = PARF(p, PO_DW_B)[l * 512 + tid];
    __syncthreads();
    {   u32x4 vv[8], gg[8];
#pragma unroll
        for (int i = 0; i < 8; ++i) { int idx = tid + 512 * i; idx = idx < 62 * 64 ? idx : 62 * 64 - 1; const int row = idx >> 6, c8 = idx & 63; const int tl = t0 - 30 + row, tc = tl > 0 ? tl : 0;
            const bf16_t* rp = PR + (size_t)(tb + tc) * NP + 8 * c8; vv[i] = *(const u32x4*)(rp + C_CV); gg[i] = *(const u32x4*)(rp + C_CG); }
#pragma unroll
        for (int i = 0; i < 8; ++i) { int idx = tid + 512 * i; idx = idx < 62 * 64 ? idx : 62 * 64 - 1; const int row = idx >> 6, c8 = idx & 63; const float mk = (float)(t0 - 30 + row >= 0);
            u32x4 o;
#pragma unroll
            for (int q = 0; q < 4; ++q) { const float v0 = u_as_f(vv[i][q] << 16), v1 = u_as_f(vv[i][q] & 0xffff0000u), g0 = u_as_f(gg[i][q] << 16), g1 = u_as_f(gg[i][q] & 0xffff0000u);
                o[q] = pk2(v0 * sigm(g0) * mk, v1 * sigm(g1) * mk); }
            *(u32x4*)(Y + row * YLD + 8 * c8) = o; }
    }
    __syncthreads();
    {
        const int c = tid;
#pragma unroll 1
        for (int g_ = 0; g_ < (PROBE_C == 1 ? 4 : 2); ++g_) { const int g = g_ & 1;
            float yin[46];
#pragma unroll
            for (int i = 0; i < 46; ++i) yin[i] = bf2f(Y[(16 * g + i) * YLD + c]);
#pragma unroll
            for (int j = 0; j < 16; ++j) { float acc = bias;
#pragma unroll
                for (int k = 0; k < 31; ++k) acc += w[k] * yin[j + k];
                cv[(16 * g + j) * LD + c] = acc; }
        }
    }
    __syncthreads();
    const bf16_t* Bw = (const bf16_t*)(p.ws + WS_PW) + (size_t)l * 512 * 512 + (size_t)(64 * wid + (lane & 15)) * 512 + 8 * (lane >> 4);
    bf16x8 bw0[8][4];
#pragma unroll
    for (int ks = 0; ks < 8; ++ks)
#pragma unroll
        for (int nt = 0; nt < 4; ++nt) bw0[ks][nt] = *(const bf16x8*)(Bw + (size_t)(16 * nt) * 512 + 32 * ks);
    f32x4 lg0, lg1, lb0, lb1;
    { const float* lgp = PARF(p, PO_LN_G) + l * 512 + 8 * lane; const float* lbp = PARF(p, PO_LN_B) + l * 512 + 8 * lane; lg0 = *(const f32x4*)lgp; lg1 = *(const f32x4*)(lgp + 4); lb0 = *(const f32x4*)lbp; lb1 = *(const f32x4*)(lbp + 4); }
    {
#pragma unroll 1
        for (int r = 0; r < 4; ++r) { const int row = 4 * wid + r; float* rp = cv + row * LD;
            const f32x4 a = *(const f32x4*)(rp + 8 * lane), bq = *(const f32x4*)(rp + 8 * lane + 4);
            const float s = (a[0] + a[1]) + (a[2] + a[3]) + (bq[0] + bq[1]) + (bq[2] + bq[3]);
            const float mean = wave_sum(s) * (1.0f / 512.0f);
            const f32x4 da = a - mean, db = bq - mean;
            const float q = (da[0] * da[0] + da[1] * da[1]) + (da[2] * da[2] + da[3] * da[3]) + (db[0] * db[0] + db[1] * db[1]) + (db[2] * db[2] + db[3] * db[3]);
            const float rstd = RSQF(wave_sum(q) * (1.0f / 512.0f) + EPS);
            f32x4 o0, o1;
#pragma unroll
            for (int i = 0; i < 4; ++i) { o0[i] = siluf(da[i] * rstd * lg0[i] + lb0[i]); o1[i] = siluf(db[i] * rstd * lg1[i] + lb1[i]); }
            *(bf16x8*)((bf16_t*)rp + 8 * lane) = pack8(o0, o1); }
    }
    __syncthreads();
    f32x4 acc[2][4];
    {
#pragma unroll
        for (int rt = 0; rt < 2; ++rt)
#pragma unroll
            for (int nt = 0; nt < 4; ++nt) acc[rt][nt] = (f32x4){0.f, 0.f, 0.f, 0.f};
        const bf16_t* Ar = (const bf16_t*)(cv + (lane & 15) * LD) + 8 * (lane >> 4);
        bf16x8 bw1[8][4];
#pragma unroll
        for (int ks = 0; ks < 8; ++ks)
#pragma unroll
            for (int nt = 0; nt < 4; ++nt) bw1[ks][nt] = *(const bf16x8*)(Bw + (size_t)(16 * nt) * 512 + 32 * (8 + ks));
#pragma unroll
        for (int ks = 0; ks < 8; ++ks) { const bf16x8 a0 = *(const bf16x8*)(Ar + 32 * ks), a1 = *(const bf16x8*)(Ar + 16 * LD * 2 + 32 * ks);
#pragma unroll
            for (int nt = 0; nt < 4; ++nt) { acc[0][nt] = MFMA16(a0, bw0[ks][nt], acc[0][nt]); acc[1][nt] = MFMA16(a1, bw0[ks][nt], acc[1][nt]); } }
#pragma unroll
        for (int ks = 0; ks < 8; ++ks) { const bf16x8 a0 = *(const bf16x8*)(Ar + 32 * (8 + ks)), a1 = *(const bf16x8*)(Ar + 16 * LD * 2 + 32 * (8 + ks));
#pragma unroll
            for (int nt = 0; nt < 4; ++nt) { acc[0][nt] = MFMA16(a0, bw1[ks][nt], acc[0][nt]); acc[1][nt] = MFMA16(a1, bw1[ks][nt], acc[1][nt]); } }
    }
    float pbv[4]; unsigned zz[4][4]; f32x2 gg4[4];
#pragma unroll
    for (int nt = 0; nt < 4; ++nt) pbv[nt] = PARF(p, PO_PW_B)[l * 512 + 64 * wid + 16 * nt + (lane & 15)];
#pragma unroll
    for (int g = 0; g < 4; ++g) load_zg<4>(p, l, zz[g], gg4[g], tb + t0 + 4 * wid, 1536 + 128 * g, C_CZ + 128 * g, lane);
    __syncthreads();
#pragma unroll
    for (int nt = 0; nt < 4; ++nt) { const int col = 64 * wid + 16 * nt + (lane & 15);
#pragma unroll
        for (int rt = 0; rt < 2; ++rt)
#pragma unroll
            for (int i = 0; i < 4; ++i) cv[(16 * rt + (lane >> 4) * 4 + i) * LD + col] = acc[rt][nt][i] + pbv[nt]; }
    __syncthreads();
#pragma unroll
    for (int g = 0; g < 4; ++g) { f32x2 v[4];
#pragma unroll
        for (int r = 0; r < 4; ++r) v[r] = *(const f32x2*)(cv + (size_t)(4 * wid + r) * LD + 128 * g + 2 * lane);
        finalize_core<4>(p, v, zz[g], gg4[g], tb + t0 + 4 * wid, 1536 + 128 * g, lane); }
}

DEV void gla_a_unit(const Params& p, int l, int u, unsigned char* lds) {
    const int tid = opaque_tid(), lane = tid & 63, wid = UNIFORM(tid >> 6);
    const int n = u & 31, h = (u >> 5) & 3, b = u >> 7; const int tok0 = b * SEQ + 64 * n;
    float* FG = (float*)lds;
    float* GT = (float*)(lds + 4096);
    bf16_t* QD = (bf16_t*)(lds + 8192);
    bf16_t* KD = (bf16_t*)(lds + 17408);
    bf16_t* KLT = (bf16_t*)(lds + 26624);
    bf16_t* VT = (bf16_t*)(lds + 35840);
    bf16_t* AT = (bf16_t*)(lds + 54272);
    const bf16_t* PR = PROJp(p);
    const int d = tid & 63, g = tid >> 6;
    float wf[16], qv[8], kv_[8];
#pragma unroll
    for (int r = 0; r < 16; ++r) wf[r] = PARF(p, PO_FG2_W)[(size_t)(l * 16 + r) * 256 + 64 * h + d];
    const float bb = PARF(p, PO_FG2_B)[l * 256 + 64 * h + d];
#pragma unroll
    for (int i = 0; i < 8; ++i) { const int c = 8 * g + i; qv[i] = bf2f(PR[(size_t)(tok0 + c) * NP + C_GQ + 64 * h + d]); kv_[i] = bf2f(PR[(size_t)(tok0 + c) * NP + C_GK + 64 * h + d]); }
    __syncthreads();
    {
#pragma unroll
        for (int i = 0; i < 2; ++i) { const int idx = tid + 512 * i, c = idx >> 4, r = idx & 15; FG[idx] = bf2f(PR[(size_t)(tok0 + c) * NP + C_FG + r]); }
        const int j = tid >> 3, ec = (tid & 7) * 16;
#pragma unroll
        for (int q = 0; q < 2; ++q) { const bf16x8 v = *(const bf16x8*)(PR + (size_t)(tok0 + j) * NP + C_GV + 128 * h + ec + 8 * q);
#pragma unroll
            for (int i = 0; i < 8; ++i) VT[(ec + 8 * q + i) * 72 + j] = (bf16_t)v[i]; }
    }
    __syncthreads();
    float lf[8];
    {   float run = 0.f;
#pragma unroll
        for (int i = 0; i < 8; ++i) { const int c = 8 * g + i; float pre = bb;
#pragma unroll
            for (int r = 0; r < 16; ++r) pre += FG[c * 16 + r] * wf[r];
            const float ls = fminf(pre, 0.f) - LOGF(1.0f + EXPF(-fabsf(pre)));
            run += ls * (1.0f / 16.0f); lf[i] = run; }
        GT[g * 64 + d] = run;
    }
    __syncthreads();
    {   float off = 0.f, tot = 0.f;
#pragma unroll
        for (int g2 = 0; g2 < 8; ++g2) { const float t = GT[g2 * 64 + d]; tot += t; if (g2 < g) off += t; }
        bf16_t* QDg = (bf16_t*)(p.ws + WS_GQD) + (size_t)u * 64 * 64;
        u32x4 klw; unsigned short klh[8];
#pragma unroll
        for (int i = 0; i < 8; ++i) { const int c = 8 * g + i; const float bc = lf[i] + off;
            const float q = qv[i], k = kv_[i];
            const bf16_t qd = f2bf(q * 0.125f * EXPF(bc)); QD[c * 72 + d] = qd; QDg[c * 64 + d] = qd;
            KD[c * 72 + d] = f2bf(k * EXPF(-bc)); klh[i] = f2bf(k * EXPF(tot - bc)); }
        klw.x = klh[0] | ((unsigned)klh[1] << 16); klw.y = klh[2] | ((unsigned)klh[3] << 16); klw.z = klh[4] | ((unsigned)klh[5] << 16); klw.w = klh[6] | ((unsigned)klh[7] << 16);
        *(u32x4*)(KLT + d * 72 + 8 * g) = klw;
        if (g == 0) ((float*)(p.ws + WS_GDEC))[(size_t)u * 64 + d] = EXPF(tot);
    }
    __syncthreads();
    {
#pragma unroll
        for (int q = 0; q < 2; ++q) { const int tl = 2 * wid + q, ct = tl >> 2, jt = tl & 3; f32x4 acc = {0.f, 0.f, 0.f, 0.f};
            if (jt <= ct) {
#pragma unroll
                for (int ks = 0; ks < 2; ++ks) { const bf16x8 a = *(const bf16x8*)(QD + (16 * ct + (lane & 15)) * 72 + 32 * ks + 8 * (lane >> 4));
                    const bf16x8 bq = *(const bf16x8*)(KD + (16 * jt + (lane & 15)) * 72 + 32 * ks + 8 * (lane >> 4)); acc = MFMA16(a, bq, acc); } }
#pragma unroll
            for (int i = 0; i < 4; ++i) { const int c = 16 * ct + (lane >> 4) * 4 + i, j = 16 * jt + (lane & 15); AT[c * 72 + j] = f2bf(j <= c ? acc[i] : 0.f); } }
    }
    __syncthreads();
    {   const int rt = wid & 3, eh = wid >> 2; unsigned* OI = (unsigned*)(p.ws + WS_GOI) + (size_t)u * 64 * 64; bf16_t* DS = (bf16_t*)(p.ws + WS_GDS) + (size_t)u * 64 * 128;
#pragma unroll
        for (int e4 = 0; e4 < 4; ++e4) { const int et = 4 * eh + e4; f32x4 aO = {0.f, 0.f, 0.f, 0.f}, aD = {0.f, 0.f, 0.f, 0.f};
#pragma unroll
            for (int ks = 0; ks < 2; ++ks) { const int ko = 32 * ks + 8 * (lane >> 4);
                const bf16x8 fa = *(const bf16x8*)(AT + (16 * rt + (lane & 15)) * 72 + ko), fk = *(const bf16x8*)(KLT + (16 * rt + (lane & 15)) * 72 + ko);
                const bf16x8 fv = *(const bf16x8*)(VT + (16 * et + (lane & 15)) * 72 + ko);
                aO = MFMA16(fa, fv, aO); aD = MFMA16(fk, fv, aD); }
            *(u32x2*)(OI + (size_t)((wid * 4 + e4) * 64 + lane) * 2) = (u32x2){pk2(aO[0], aO[1]), pk2(aO[2], aO[3])};
            *(u32x2*)(DS + (size_t)(16 * et + (lane & 15)) * 64 + 16 * rt + (lane >> 4) * 4) = (u32x2){pk2(aD[0], aD[1]), pk2(aD[2], aD[3])}; }
    }
}

DEV void gla_scan(const Params& p, int gtid, int gstride) {
    const unsigned* DS = (const unsigned*)(p.ws + WS_GDS); const float* DEC = (const float*)(p.ws + WS_GDEC); unsigned* ST = (unsigned*)(p.ws + WS_GST);
    for (int g = gtid; g < BATCH * 4 * 4096; g += gstride) { const int bh = g >> 12, r2 = g & 4095, d = (2 * r2) & 63; float s0 = 0.f, s1 = 0.f;
        unsigned ds[32]; f32x2 dc[32];
#pragma unroll
        for (int n = 0; n < 32; ++n) { const size_t un = (size_t)bh * 32 + n; ds[n] = DS[un * 4096 + r2]; dc[n] = *(const f32x2*)(DEC + un * 64 + d); }
#pragma unroll
        for (int n = 0; n < 32; ++n) { const size_t un = (size_t)bh * 32 + n; ST[un * 4096 + r2] = pk2(s0, s1); s0 = dc[n][0] * s0 + u_as_f(ds[n] << 16); s1 = dc[n][1] * s1 + u_as_f(ds[n] & 0xffff0000u); } }
}
DEV void lru_scan(const Params& p, int gtid, int gstride) {
    const float* LE = (const float*)(p.ws + WS_LP); float* CAR = (float*)(p.ws + WS_LCAR);
    for (int g = gtid; g < BATCH * 512; g += gstride) { const int b = g >> 9, ch = g & 511; float carry = 0.f; float lh[32], lp[32];
#pragma unroll
        for (int n = 0; n < 32; ++n) { const size_t e = (size_t)(b * 32 + n) * 1024 + ch; lh[n] = LE[e]; lp[n] = LE[e + 512]; }
#pragma unroll
        for (int n = 0; n < 32; ++n) { CAR[(size_t)(b * 32 + n) * 512 + ch] = carry; carry = lp[n] * carry + lh[n]; } }
}
DEV void gla_c_wave(const Params& p, int l, int wu, int lane, float* tile) {
    const int rt = wu & 3, u = wu >> 2; const int n = u & 31, h = (u >> 5) & 3, b = u >> 7; const int tok0 = b * SEQ + 64 * n + 16 * rt;
    const bf16_t* QDg = (const bf16_t*)(p.ws + WS_GQD) + (size_t)u * 64 * 64; const bf16_t* ST = (const bf16_t*)(p.ws + WS_GST) + (size_t)u * 8192;
    const unsigned* OI = (const unsigned*)(p.ws + WS_GOI) + (size_t)u * 64 * 64;
    f32x4 acc[8]; u32x2 oi[8]; bf16x8 a[2], bs[8][2]; unsigned zz[16]; f32x2 g;
#pragma unroll
    for (int ks = 0; ks < 2; ++ks) a[ks] = *(const bf16x8*)(QDg + (16 * rt + (lane & 15)) * 64 + 32 * ks + 8 * (lane >> 4));
#pragma unroll
    for (int et = 0; et < 8; ++et)
#pragma unroll
        for (int ks = 0; ks < 2; ++ks) bs[et][ks] = *(const bf16x8*)(ST + (16 * et + (lane & 15)) * 64 + 32 * ks + 8 * (lane >> 4));
#pragma unroll
    for (int et = 0; et < 8; ++et) oi[et] = *(const u32x2*)(OI + (size_t)(((rt + 4 * (et >> 2)) * 4 + (et & 3)) * 64 + lane) * 2);
    load_zg<16>(p, l, zz, g, tok0, 128 * h, C_GZ + 128 * h, lane);
#pragma unroll
    for (int et = 0; et < 8; ++et) { acc[et] = (f32x4){u_as_f(oi[et][0] << 16), u_as_f(oi[et][0] & 0xffff0000u), u_as_f(oi[et][1] << 16), u_as_f(oi[et][1] & 0xffff0000u)};
#pragma unroll
        for (int ks = 0; ks < 2; ++ks) acc[et] = MFMA16(a[ks], bs[et][ks], acc[et]); }
    WAVE_SYNC();
#pragma unroll
    for (int et = 0; et < 8; ++et)
#pragma unroll
        for (int i = 0; i < 4; ++i) tile[((lane >> 4) * 4 + i) * 128 + 16 * et + (lane & 15)] = acc[et][i];
    WAVE_SYNC();
    f32x2 v[16];
#pragma unroll
    for (int r = 0; r < 16; ++r) v[r] = *(const f32x2*)(tile + r * 128 + 2 * lane);
    finalize_core<16>(p, v, zz, g, tok0, 128 * h, lane);
    WAVE_SYNC();
}
DEV void lru_b_wave(const Params& p, int l, int wu, int lane) {
    const int t8 = wu & 7, hh = (wu >> 3) & 3, n = (wu >> 5) & 31, b = wu >> 10; const int ch = 128 * hh + 2 * lane; const int tok0 = b * SEQ + 64 * n + 8 * t8;
    const f32x2 carry = *(const f32x2*)((const float*)(p.ws + WS_LCAR) + (size_t)(b * 32 + n) * 512 + ch);
    const unsigned* LHP = (const unsigned*)(p.ws + WS_LH) + (size_t)tok0 * 512 + ch;
    u32x2 hp[8]; f32x2 v[8]; unsigned zz[8]; f32x2 g;
#pragma unroll
    for (int r = 0; r < 8; ++r) hp[r] = *(const u32x2*)(LHP + (size_t)r * 512);
    load_zg<8>(p, l, zz, g, tok0, 512 + 128 * hh, C_LZ + 128 * hh, lane);
#pragma unroll
    for (int r = 0; r < 8; ++r) { v[r][0] = u_as_f(hp[r][0] << 16) + u_as_f(hp[r][0] & 0xffff0000u) * carry[0]; v[r][1] = u_as_f(hp[r][1] << 16) + u_as_f(hp[r][1] & 0xffff0000u) * carry[1]; }
    finalize_core<8>(p, v, zz, g, tok0, 512 + 128 * hh, lane);
}
constexpr int NW_GLAC = BATCH * 4 * 32 * 4, NW_LRUB = BATCH * 32 * 4 * 8;

DEV void lru_a_unit(const Params& p, int l, int u, unsigned char* lds) {
    const int tid = opaque_tid(), lane = tid & 63, wid = UNIFORM(tid >> 6);
    const int hh = u & 3, n = (u >> 2) & 31, b = u >> 7; const int tb = b * SEQ;
    bf16_t* XC = (bf16_t*)lds;
    float* GR = (float*)(lds + 17408);
    float* GI = (float*)(lds + 50176);
    float* SUM = (float*)(lds + 82944);
    bf16_t* XIN = (bf16_t*)(lds + 87040);
    const bf16_t* PR = PROJp(p);
    const int c = tid & 127, tg = tid >> 7, ch = 128 * hh + c;
    float xc[16];
    const int gate = wid >> 2, jq = wid & 3;
    u32x4 xt[3];
#pragma unroll
    for (int i = 0; i < 3; ++i) { int idx = tid + 512 * i; idx = idx < 67 * 16 ? idx : 67 * 16 - 1; const int row = idx >> 4, c8 = idx & 15; const int tl = 64 * n - 3 + row, tc = tl > 0 ? tl : 0;
        xt[i] = *(const u32x4*)(PR + (size_t)(tb + tc) * NP + C_LX + 128 * hh + 8 * c8); if (tl < 0) xt[i] = (u32x4){0u, 0u, 0u, 0u}; }
    bf16x8 bwf[4][2];
    {   const bf16_t* Bw = (const bf16_t*)(p.ws + WS_LRU) + (size_t)((l * 4 + hh) * 2 + gate) * 128 * 128;
#pragma unroll
        for (int ks = 0; ks < 4; ++ks)
#pragma unroll
            for (int j2 = 0; j2 < 2; ++j2) bwf[ks][j2] = *(const bf16x8*)(Bw + (size_t)(16 * (2 * jq + j2) + (lane & 15)) * 128 + 32 * ks + 8 * (lane >> 4)); }
    const float lam = PARF(p, PO_LLAM)[l * 512 + ch];
    float gbias[2];
    { const float* bias = PARF(p, gate ? PO_LBX : PO_LBA) + l * 512 + 128 * hh;
#pragma unroll
      for (int j2 = 0; j2 < 2; ++j2) gbias[j2] = bias[16 * (2 * jq + j2) + (lane & 15)]; }
    float w4[4];
#pragma unroll
    for (int k = 0; k < 4; ++k) w4[k] = PARF(p, PO_LCONV_W)[(size_t)(l * 4 + k) * 512 + ch];
    const float cb = PARF(p, PO_LCONV_B)[l * 512 + ch];
#pragma unroll
    for (int i = 0; i < 3; ++i) { const int idx = tid + 512 * i; if (idx < 67 * 16) *(u32x4*)(XIN + (idx >> 4) * 136 + 8 * (idx & 15)) = xt[i]; }
    __syncthreads();
    {   float xin[19];
#pragma unroll
        for (int i = 0; i < 19; ++i) xin[i] = bf2f(XIN[(16 * tg + i) * 136 + c]);
#pragma unroll
        for (int j = 0; j < 16; ++j) { float a = cb;
#pragma unroll
            for (int k = 0; k < 4; ++k) a += w4[k] * xin[j + k];
            xc[j] = a; XC[(16 * tg + j) * 136 + c] = f2bf(a); }
    }
    __syncthreads();
    {   f32x4 acc[4][2];
#pragma unroll
        for (int rt = 0; rt < 4; ++rt)
#pragma unroll
            for (int j2 = 0; j2 < 2; ++j2) acc[rt][j2] = (f32x4){0.f, 0.f, 0.f, 0.f};
#pragma unroll
        for (int ks = 0; ks < 4; ++ks)
#pragma unroll
            for (int rt = 0; rt < 4; ++rt) { const bf16x8 a = *(const bf16x8*)(XC + (16 * rt + (lane & 15)) * 136 + 32 * ks + 8 * (lane >> 4));
#pragma unroll
                for (int j2 = 0; j2 < 2; ++j2) acc[rt][j2] = MFMA16(a, bwf[ks][j2], acc[rt][j2]); }
        float* G = gate ? GI : GR;
#pragma unroll
        for (int j2 = 0; j2 < 2; ++j2) { const float bj = gbias[j2]; const int col = 16 * (2 * jq + j2) + (lane & 15);
#pragma unroll
            for (int rt = 0; rt < 4; ++rt)
#pragma unroll
                for (int i = 0; i < 4; ++i) G[(16 * rt + (lane >> 4) * 4 + i) * 128 + col] = sigm(acc[rt][j2][i] + bj); }
    }
    __syncthreads();
    float hl[16], pl[16];
    {   const float sp = fmaxf(-lam, 0.f) + log1pf(expf(-fabsf(lam)));
        float hs = 0.f, ps = 1.f;
#pragma unroll
        for (int j = 0; j < 16; ++j) { const int t = 16 * tg + j; const float r = GR[t * 128 + c], ig = GI[t * 128 + c];
            const float la = -8.0f * r * sp, a = EXPF(la), uu = sqrtf(fmaxf(1.0f - a * a, 0.f)) * (ig * xc[j]);
            hs = a * hs + uu; ps *= a; hl[j] = hs; pl[j] = ps; }
        SUM[(tg * 128 + c) * 2] = hs; SUM[(tg * 128 + c) * 2 + 1] = ps;
    }
    __syncthreads();
    {   float carry = 0.f, pp = 1.f;
#pragma unroll
        for (int s = 0; s < 3; ++s) if (s < tg) { const float hs = SUM[(s * 128 + c) * 2], ps = SUM[(s * 128 + c) * 2 + 1]; carry = ps * carry + hs; pp *= ps; }
        unsigned* LHP = (unsigned*)(p.ws + WS_LH);
#pragma unroll
        for (int j = 0; j < 16; ++j) { const size_t idx = (size_t)(tb + 64 * n + 16 * tg + j) * 512 + ch; LHP[idx] = pk2(hl[j] + pl[j] * carry, pl[j] * pp); }
        if (tg == 3) { float* LE = (float*)(p.ws + WS_LP) + (size_t)(b * 32 + n) * 1024 + ch; LE[0] = hl[15] + pl[15] * carry; LE[512] = pl[15] * pp; }
    }
}
constexpr size_t WS_FLG = 49152;
#ifdef CPU_EMU
DEV void flag_signal(unsigned* f) { __syncthreads(); if (threadIdx.x == 0) *f += 1u; }
DEV void flag_wait(unsigned* f, unsigned want) { __syncthreads(); (void)f; (void)want; }
#else
DEV void flag_signal(unsigned* f) {
    asm volatile("s_waitcnt vmcnt(0)" ::: "memory"); __syncthreads();
    if (threadIdx.x == 0) { __builtin_amdgcn_fence(__ATOMIC_RELEASE, "agent"); asm volatile("s_waitcnt vmcnt(0)" ::: "memory"); __hip_atomic_fetch_add(f, 1u, __ATOMIC_RELAXED, __HIP_MEMORY_SCOPE_AGENT); }
}
DEV void flag_wait(unsigned* f, unsigned want) {
    if (threadIdx.x == 0) { unsigned sp = 0u; while (__hip_atomic_load(f, __ATOMIC_RELAXED, __HIP_MEMORY_SCOPE_AGENT) < want && ++sp < (1u << 22)) __builtin_amdgcn_s_sleep(2);
        __builtin_amdgcn_fence(__ATOMIC_ACQUIRE, "agent"); asm volatile("s_waitcnt vmcnt(0)" ::: "memory"); }
    __syncthreads();
}
#endif

#ifdef CPU_EMU
DEV unsigned part_arrive(unsigned* c) { const unsigned t = *c; *c = t + 1u; return t; }
#else
DEV unsigned part_arrive(unsigned* c) { __builtin_amdgcn_fence(__ATOMIC_RELEASE, "agent"); asm volatile("s_waitcnt vmcnt(0)" ::: "memory"); return __hip_atomic_fetch_add(c, 1u, __ATOMIC_RELAXED, __HIP_MEMORY_SCOPE_AGENT); }
#endif
DEV void cmp_unit(const Params& p, int l, int u, unsigned char* lds) {
    const int tid = opaque_tid(), lane = tid & 63, wid = UNIFORM(tid >> 6);
    const int ksl = u & 3, grp = u >> 2; const int rt = grp % 9, b = (grp / 9) % BATCH, kv = grp / (9 * BATCH); const int n0 = 15 * rt, tb = b * SEQ;
    bf16_t* ZS = (bf16_t*)lds;
    bf16_t* POSF = (bf16_t*)(lds + 32768);
    bf16_t* HID = (bf16_t*)(lds + 36864);
    unsigned* TICK = (unsigned*)(lds + 43008);
    const int r = lane & 15, kq = lane >> 4;
    bf16x8 bw[32], w2f[4];
    { const bf16_t* bp = (const bf16_t*)(p.ws + WS_W1) + (size_t)(l * 2 + kv) * 128 * 4096 + (size_t)(16 * wid + r) * 4096 + 1024 * ksl + 8 * kq;
#pragma unroll
      for (int i = 0; i < 32; ++i) bw[i] = *(const bf16x8*)(bp + 32 * i); }
    { const bf16_t* bp2 = (const bf16_t*)(p.ws + WS_W2) + (size_t)(l * 2 + kv) * 128 * 128 + (size_t)(16 * wid + r) * 128 + 8 * kq;
#pragma unroll
      for (int ks = 0; ks < 4; ++ks) w2f[ks] = *(const bf16x8*)(bp2 + 32 * ks); }
    __syncthreads();
#pragma unroll
    for (int i = 0; i < 4; ++i) { int idx = tid + 512 * i; idx = idx < 15 * 8 * 16 ? idx : 15 * 8 * 16 - 1; const int c8 = idx & 15, t8 = (idx >> 4) & 7, rr = idx >> 7;
        const int tl = 16 * (n0 + rr) + 8 * ksl + t8; const int tc = tl < SEQ ? tl : SEQ - 1;
        u32x4 v = *(const u32x4*)((const bf16_t*)(p.ws + WS_KVC) + (size_t)(tb + tc) * 256 + (kv ? 128 : 0) + 8 * c8);
        if (tl >= SEQ) v = (u32x4){0u, 0u, 0u, 0u};
        *(u32x4*)(ZS + (rr * 8 + t8) * 128 + 8 * (c8 ^ rr)) = v; }
    if (tid < 128) { const float* pos = PARF(p, kv ? PO_POSV : PO_POSK) + (size_t)l * 4096 + 1024 * ksl + 8 * tid;
        const f32x4 a = *(const f32x4*)pos, bq = *(const f32x4*)(pos + 4); *(bf16x8*)(POSF + 8 * tid) = pack8(a, bq); }
    __syncthreads();
    f32x4 acc = {0.f, 0.f, 0.f, 0.f};
#pragma unroll
    for (int i = 0; i < 32; ++i) { const int t8 = i >> 2, c = 4 * (i & 3) + kq;
        const bf16_t* ap = r < 15 ? ZS + (r * 8 + t8) * 128 + 8 * (c ^ r) : POSF + 32 * i + 8 * kq;
        const bf16x8 a = *(const bf16x8*)ap; acc = MFMA16(a, bw[i], acc); }
    float* PART = (float*)(p.ws + WS_CPART) + (size_t)grp * 4 * 2048;
    *(f32x4*)(PART + (size_t)ksl * 2048 + (wid * 64 + lane) * 4) = acc;
#ifndef CPU_EMU
    asm volatile("s_waitcnt vmcnt(0)" ::: "memory");
#endif
    __syncthreads();
    if (tid == 0) *TICK = part_arrive((unsigned*)(p.ws + WS_CCNT) + (size_t)l * (2 * BATCH * 9) + grp);
    __syncthreads();
    if (*TICK != 3u) return;
#ifndef CPU_EMU
    if (tid == 0) { __builtin_amdgcn_fence(__ATOMIC_ACQUIRE, "agent"); asm volatile("s_waitcnt vmcnt(0)" ::: "memory"); }
#endif
    __syncthreads();
    {   f32x4 s4 = {0.f, 0.f, 0.f, 0.f};
#pragma unroll
        for (int q = 0; q < 4; ++q) s4 = s4 + *(const f32x4*)(PART + (size_t)q * 2048 + (wid * 64 + lane) * 4);
        const float posv = SHFL(s4[3], 48 + (lane & 15));
#pragma unroll
        for (int i = 0; i < 4; ++i) { const int row = (lane >> 4) * 4 + i; HID[row * 136 + 16 * wid + (lane & 15)] = f2bf(siluf(s4[i] + posv)); }
    }
    __syncthreads();
    {   f32x4 a2 = {0.f, 0.f, 0.f, 0.f};
#pragma unroll
        for (int ks = 0; ks < 4; ++ks) { const bf16x8 a = *(const bf16x8*)(HID + (lane & 15) * 136 + 32 * ks + 8 * (lane >> 4)); a2 = MFMA16(a, w2f[ks], a2); }
        bf16_t* KC = (bf16_t*)(p.ws + WS_KCMP) + (size_t)(kv * BATCH + b) * 128 * 128;
#pragma unroll
        for (int i = 0; i < 4; ++i) { const int row = (lane >> 4) * 4 + i, nn = n0 + row;
            if (row < 15 && nn < 128) KC[nn * 128 + 16 * wid + (lane & 15)] = nn < 127 ? f2bf(a2[i]) : (bf16_t)0; }
    }
    flag_signal((unsigned*)(p.ws + WS_FLG) + (size_t)(l * BATCH + b) * 64);
}

namespace nsa {
constexpr int SHM_K = 16384, SHM_V = 16384;
constexpr int L_V = 0, L_K = 32768, L_WSC = 65536, L_SELM = 67584, L_UNI = 67840, L_CS = 68096, L_IMP = 133632;
constexpr float SCALE = 0.08838834764831845f, C2 = 1.4426950408889634f * SCALE, THR = 8.f;
#define KSWZ(row, colB) ((row) * 256 + ((colB) ^ (((row) & 7) << 4)))
DEV int v_st(int k, int c) { const int kk = (k & ~0xC) | ((k & 4) << 1) | ((k & 8) >> 1); return ((kk >> 3) * 4 + (c >> 5)) * 512 + ((kk & 7) * 32 + (c & 31)) * 2; }
DEV int v_rd_base(int lane) { return ((lane & 3) << 3) | (((lane >> 2) & 3) << 6) | (((lane >> 4) & 1) << 5) | (((lane >> 5) & 1) << 8); }
DEV int crow(int r, int hi) { return (r & 3) + 8 * (r >> 2) + 4 * hi; }
DEV void partialSM(f32x16& p0, f32x16& p1, float& m_reg, float& alpha) {
    float pmax = p0[0];
#pragma unroll
    for (int r = 1; r < 16; ++r) pmax = fmaxf(pmax, p0[r]);
#pragma unroll
    for (int r = 0; r < 16; ++r) pmax = fmaxf(pmax, p1[r]);
    { auto rr = PLSWAP(f_as_u(pmax), f_as_u(pmax)); pmax = fmaxf(u_as_f(rr[0]), u_as_f(rr[1])); }
    float mn;
    if (ALL((pmax - m_reg) * SCALE <= THR)) { mn = m_reg; alpha = 1.f; }
    else { mn = fmaxf(m_reg, pmax); alpha = EXP2F((m_reg - mn) * C2); m_reg = mn; }
    const float mnL = -mn * C2;
#pragma unroll
    for (int r = 0; r < 16; ++r) { p0[r] = EXP2F(fmaf(p0[r], C2, mnL)); p1[r] = EXP2F(fmaf(p1[r], C2, mnL)); }
}
DEV void packP(const f32x16& p0, const f32x16& p1, bf16x8& pa0, bf16x8& pa1, bf16x8& pa2, bf16x8& pa3) {
#define PK4(P, B_, OUT) do { unsigned a0 = cvtpk(P[B_ + 0], P[B_ + 1]), a1 = cvtpk(P[B_ + 2], P[B_ + 3]); unsigned b0 = cvtpk(P[B_ + 4], P[B_ + 5]), b1 = cvtpk(P[B_ + 6], P[B_ + 7]); \
        auto r0 = PLSWAP(a0, b0); auto r1 = PLSWAP(a1, b1); u32x4 w = {r0[0], r1[0], r0[1], r1[1]}; OUT = __builtin_bit_cast(bf16x8, w); } while (0)
    PK4(p0, 0, pa0); PK4(p0, 8, pa1); PK4(p1, 0, pa2); PK4(p1, 8, pa3);
#undef PK4
}
DEV float rowsum2(const f32x16& p0, const f32x16& p1) {
    float ps = 0.f;
#pragma unroll
    for (int r = 0; r < 16; ++r) ps += p0[r];
#pragma unroll
    for (int r = 0; r < 16; ++r) ps += p1[r];
    auto rr = PLSWAP(f_as_u(ps), f_as_u(ps)); return u_as_f(rr[0]) + u_as_f(rr[1]);
}
template <int KB> DEV void qkt(f32x16& p0, f32x16& p1, const unsigned char* K_lds, int r32, int hi, const bf16x8* qr) {
#pragma unroll
    for (int r = 0; r < 16; ++r) { p0[r] = 0.f; p1[r] = 0.f; }
    const unsigned char* kb[4];
#pragma unroll
    for (int dd = 0; dd < 4; ++dd) kb[dd] = K_lds + KB * SHM_K + KSWZ(r32, (dd * 16 + hi * 8) * 2);
#pragma unroll
    for (int d0 = 0; d0 < 8; ++d0) { const unsigned char* a = kb[d0 & 3] + (d0 >> 2) * 128;
        const bf16x8 b0 = *(const bf16x8*)a, b1 = *(const bf16x8*)(a + 32 * 256);
        p0 = MFMA32(b0, qr[d0], p0); p1 = MFMA32(b1, qr[d0], p1); }
}
template <int VB> DEV void pv_tile(f32x16* o, unsigned vb0, bf16x8 pa0, bf16x8 pa1, bf16x8 pa2, bf16x8 pa3) {
#define PV_D0(d0) do { s16x4 l0, l1, l2, l3, h0, h1, h2, h3; constexpr int b_ = VB * SHM_V + (d0) * 512; \
        TRREAD(l0, vb0, b_); TRREAD(h0, vb0, b_ + 2048); TRREAD(l1, vb0, b_ + 4096); TRREAD(h1, vb0, b_ + 6144); TRREAD(l2, vb0, b_ + 8192); TRREAD(h2, vb0, b_ + 10240); TRREAD(l3, vb0, b_ + 12288); TRREAD(h3, vb0, b_ + 14336); \
        LGKM0(); SBAR(); \
        o[d0] = MFMA32(pa0, ((bf16x8){l0[0], l0[1], l0[2], l0[3], h0[0], h0[1], h0[2], h0[3]}), o[d0]); \
        o[d0] = MFMA32(pa1, ((bf16x8){l1[0], l1[1], l1[2], l1[3], h1[0], h1[1], h1[2], h1[3]}), o[d0]); \
        o[d0] = MFMA32(pa2, ((bf16x8){l2[0], l2[1], l2[2], l2[3], h2[0], h2[1], h2[2], h2[3]}), o[d0]); \
        o[d0] = MFMA32(pa3, ((bf16x8){l3[0], l3[1], l3[2], l3[3], h3[0], h3[1], h3[2], h3[3]}), o[d0]); } while (0)
    PV_D0(0); PV_D0(1); PV_D0(2); PV_D0(3);
#undef PV_D0
}
struct KVRegs { bf16x8 k0, k1, v0, v1; };
DEV void kv_load(KVRegs& r, const bf16_t* Kg, const bf16_t* Vg, size_t ld, int tid) {
    const int sr = tid >> 4, sc = (tid & 15) * 8;
    r.k0 = *(const bf16x8*)(Kg + (size_t)sr * ld + sc); r.k1 = *(const bf16x8*)(Kg + (size_t)(32 + sr) * ld + sc);
    r.v0 = *(const bf16x8*)(Vg + (size_t)sr * ld + sc); r.v1 = *(const bf16x8*)(Vg + (size_t)(32 + sr) * ld + sc);
}
DEV void kv_write(const KVRegs& r, unsigned char* lds, int kbuf, int vbuf, int tid) {
    const int sr = tid >> 4, sc = (tid & 15) * 8;
    unsigned char* Kl = lds + L_K + kbuf * SHM_K; unsigned char* Vl = lds + L_V + vbuf * SHM_V; const int kws = KSWZ(sr, sc * 2);
    *(bf16x8*)(Kl + kws) = r.k0; *(bf16x8*)(Kl + kws + 32 * 256) = r.k1;
    *(bf16x8*)(Vl + v_st(sr, sc)) = r.v0; *(bf16x8*)(Vl + v_st(32 + sr, sc)) = r.v1;
}
DEV void stage_kv(const bf16_t* Kg, const bf16_t* Vg, size_t ld, unsigned char* lds, int kbuf, int vbuf, int tid) { KVRegs r; kv_load(r, Kg, Vg, ld, tid); kv_write(r, lds, kbuf, vbuf, tid); }
DEV void kv_dma(const bf16_t* Kg, const bf16_t* Vg, size_t ld, unsigned char* lds, int buf, int wid, int lane) {
#pragma unroll
    for (int ii = 0; ii < 2; ++ii) { const int i = 2 * wid + ii, L = i * 1024 + lane * 16;
        { const int row = L >> 8, c = (L >> 4) & 15, cs = c ^ (row & 7); GLDS16(Kg + (size_t)row * ld + cs * 8, lds + L_K + buf * SHM_K + i * 1024); }
        { const int sb = L >> 9, o_ = L & 511, kk = (sb >> 2) * 8 + (o_ >> 6), c = (sb & 3) * 32 + ((o_ & 63) >> 1); const int k = (kk & ~0xC) | ((kk & 4) << 1) | ((kk & 8) >> 1);
          GLDS16(Vg + (size_t)k * ld + c, lds + L_V + buf * SHM_V + i * 1024); } }
}
}

#ifndef NSA_SPLIT_QB
#define NSA_SPLIT_QB 16
#endif
DEV int nsa_nparts(int qb) { return qb < NSA_SPLIT_QB ? 1 : 2; }
DEV void nsa_range(int qb, int k, int K, int& lo, int& hi_) {
    const int ns = qb + 1, nw = ns < 9 ? ns : 9;
    if (K == 1) { lo = 0; hi_ = ns; return; }
    const int tgt2 = (K * 5 + 2 + 2 * (nw + ns)) / K;
    int al = (tgt2 - 5 - 2 * nw) / 2; if (al < 0) al = 0;
    int a0 = K == 2 ? ns - al : (tgt2 - 7) / 2; if (a0 < 1) a0 = 1; if (a0 > ns - al) a0 = ns - al;
    if (k == 0) { lo = 0; hi_ = a0; } else if (k == K - 1) { lo = ns - al; hi_ = ns; } else { lo = a0; hi_ = ns - al; }
}
constexpr size_t NSA_PART_BYTES = 256 * 128 * 4;
DEV int nsa_frag_idx(int wid, int lane, int d0, int q) { return (((wid * 4 + d0) * 4 + q) * 64 + lane) * 4; }
DEV void nsa_part(const Params& p, int l, int b, int qb, int k, int K, unsigned char* lds, bool dry = false) {
    using namespace nsa;
    const int tid = opaque_tid(), lane = tid & 63, wid = UNIFORM(tid >> 6), r32 = lane & 31, hi = lane >> 5;
    const int tb = b * SEQ, t0 = 64 * qb;
    const int head = wid >> 1, tau = 32 * (wid & 1) + r32, pos = t0 + tau;
    const bf16_t* PR = PROJp(p); const bf16_t* KVS = (const bf16_t*)(p.ws + WS_KVC) + (size_t)1 * T * 256; const bf16_t* KVW = (const bf16_t*)(p.ws + WS_KVC) + (size_t)2 * T * 256;
    float* wsc = (float*)(lds + L_WSC) + wid * 64; float* li_l = wsc; float* al_l = wsc + 32;
    unsigned* SELM = (unsigned*)(lds + L_SELM); unsigned* UNI = (unsigned*)(lds + L_UNI);
    float* CS = (float*)(lds + L_CS); float* IMP = (float*)(lds + L_IMP);
    const unsigned vb0 = LDS_ADDR(lds + L_V) + v_rd_base(lane);
    const int pid0 = (b * 32 + qb) * 3;
    float* ACCb = (float*)(p.ws + WS_NACC + (size_t)(pid0 + k) * NSA_PART_BYTES);
    float* SLCb = (float*)(p.ws + WS_NSLC + (size_t)(pid0 + k) * NSA_PART_BYTES);
    const bool has_win = (k == K - 1), has_cmp = (k == 0);
    bf16x8 qr[8];
#pragma unroll
    for (int d0 = 0; d0 < 8; ++d0) qr[d0] = *(const bf16x8*)(PR + (size_t)(tb + pos) * NP + C_NQ + 128 * head + 16 * d0 + 8 * hi);
    float gs[3];
#pragma unroll
    for (int i = 0; i < 3; ++i) gs[i] = sigm(bf2f(PR[(size_t)(tb + pos) * NP + C_NG + 3 * head + i]));
    f32x16 o[4]; float m_reg, l_reg, alpha; bf16x8 pa0, pa1, pa2, pa3;
    const float NEG = -__builtin_inff();
#define ZERO_O() do { _Pragma("unroll") for (int d_ = 0; d_ < 4; ++d_) _Pragma("unroll") for (int r = 0; r < 16; ++r) o[d_][r] = 0.f; } while (0)
#define RESC(a) do { if (ANY((a) < 1.f)) { if (hi == 0) al_l[r32] = (a); WAVE_SYNC(); \
        _Pragma("unroll") for (int d_ = 0; d_ < 4; ++d_) _Pragma("unroll") for (int r = 0; r < 16; ++r) o[d_][r] *= al_l[crow(r, hi)]; WAVE_SYNC(); } } while (0)
#define ROWFAC(fac, f) do { WAVE_SYNC(); if (hi == 0) li_l[r32] = (fac); WAVE_SYNC(); _Pragma("unroll") for (int r = 0; r < 16; ++r) f[r] = li_l[crow(r, hi)]; WAVE_SYNC(); } while (0)
    if (has_win) {   m_reg = -1e30f; l_reg = 0.f; ZERO_O();
        const int jlo = qb - 8 > 0 ? qb - 8 : 0; int cur = 0;
        __syncthreads();
        kv_dma(KVW + (size_t)(tb + 64 * jlo) * 256, KVW + (size_t)(tb + 64 * jlo) * 256 + 128, 256, lds, 0, wid, lane);
        DMA_WAIT(); __syncthreads();
#pragma unroll 1
        for (int j = jlo; j <= qb; ++j) {
            if (j < qb) kv_dma(KVW + (size_t)(tb + 64 * (j + 1)) * 256, KVW + (size_t)(tb + 64 * (j + 1)) * 256 + 128, 256, lds, cur ^ 1, wid, lane);
            f32x16 p0, p1; qkt<0>(p0, p1, lds + L_K + cur * SHM_K, r32, hi, qr);
            if (j == qb || j == qb - 8) { const int dq = pos - 64 * j;
#pragma unroll
                for (int r = 0; r < 16; ++r) { const int c = crow(r, hi); if ((unsigned)(dq - c) >= 512u) p0[r] = NEG; if ((unsigned)(dq - c - 32) >= 512u) p1[r] = NEG; } }
            partialSM(p0, p1, m_reg, alpha); RESC(alpha);
            l_reg = l_reg * alpha + rowsum2(p0, p1);
            packP(p0, p1, pa0, pa1, pa2, pa3); pv_tile<0>(o, vb0 + cur * SHM_V, pa0, pa1, pa2, pa3);
            DMA_WAIT(); __syncthreads(); cur ^= 1;
        }
        float f[16]; ROWFAC(gs[2] / l_reg, f);
        float* ap = ACCb; LAUNDER(ap);
#pragma unroll
        for (int d0 = 0; d0 < 4; ++d0)
#pragma unroll
            for (int q = 0; q < 4; ++q) *(f32x4*)(ap + nsa_frag_idx(wid, lane, d0, q)) = (f32x4){o[d0][4 * q] * f[4 * q], o[d0][4 * q + 1] * f[4 * q + 1], o[d0][4 * q + 2] * f[4 * q + 2], o[d0][4 * q + 3] * f[4 * q + 3]};
    }
    flag_wait((unsigned*)(p.ws + WS_FLG) + (size_t)(l * BATCH + b) * 64, 18u);
    {   const bf16_t* KC = (const bf16_t*)(p.ws + WS_KCMP) + (size_t)(0 * BATCH + b) * 128 * 128; const bf16_t* VC = (const bf16_t*)(p.ws + WS_KCMP) + (size_t)(1 * BATCH + b) * 128 * 128;
        stage_kv(KC, VC, 128, lds, 0, 0, tid); stage_kv(KC + 64 * 128, VC + 64 * 128, 128, lds, 1, 1, tid);
        if (tid == 0) *UNI = 0u;
    }
    __syncthreads();
    {
        float mx = -1e30f, lsum = 0.f;
#define CMASK(P0, P1, kb) do { _Pragma("unroll") for (int r = 0; r < 16; ++r) { const int n = 64 * (kb) + crow(r, hi); \
            if (pos < 16 * n + 31) P0[r] = NEG; if (pos < 16 * (n + 32) + 31 || n + 32 >= 127) P1[r] = NEG; } } while (0)
#define CPASS1(kb) do { f32x16 p0, p1; qkt<kb>(p0, p1, lds + L_K, r32, hi, qr); CMASK(p0, p1, kb); float tm = mx; \
            _Pragma("unroll") for (int r = 0; r < 16; ++r) tm = fmaxf(tm, fmaxf(p0[r], p1[r])); \
            { auto rr = PLSWAP(f_as_u(tm), f_as_u(tm)); tm = fmaxf(u_as_f(rr[0]), u_as_f(rr[1])); } \
            const float mnL = -tm * C2; \
            _Pragma("unroll") for (int r = 0; r < 16; ++r) { p0[r] = EXP2F(fmaf(p0[r], C2, mnL)); p1[r] = EXP2F(fmaf(p1[r], C2, mnL)); } \
            lsum = lsum * EXP2F((mx - tm) * C2) + rowsum2(p0, p1); mx = tm; } while (0)
        CPASS1(0); CPASS1(1);
        const float inv = lsum > 0.f ? 1.0f / lsum : 0.f; const float mnL2 = -mx * C2;
        float* csr = CS + (size_t)((head * 64 + tau) * 32) * 2;
        ZERO_O();
#define CSW(P, s) do { _Pragma("unroll") for (int q = 0; q < 4; ++q) { const int g = 8 * (s) + 2 * q + hi; *(f32x2*)(csr + 2 * g) = (f32x2){(P[4 * q] + P[4 * q + 1]) + (P[4 * q + 2] + P[4 * q + 3]), P[4 * q + 3]}; } } while (0)
#define CPASS2(kb) do { f32x16 p0, p1; qkt<kb>(p0, p1, lds + L_K, r32, hi, qr); CMASK(p0, p1, kb); \
            _Pragma("unroll") for (int r = 0; r < 16; ++r) { p0[r] = EXP2F(fmaf(p0[r], C2, mnL2)) * inv; p1[r] = EXP2F(fmaf(p1[r], C2, mnL2)) * inv; } \
            CSW(p0, 2 * (kb)); CSW(p1, 2 * (kb) + 1); if (has_cmp) { packP(p0, p1, pa0, pa1, pa2, pa3); pv_tile<kb>(o, vb0, pa0, pa1, pa2, pa3); } } while (0)
        CPASS2(0); CPASS2(1);
#undef CSW
#undef CPASS1
#undef CPASS2
#undef CMASK
        if (has_cmp) {
            float f[16]; ROWFAC(gs[0], f);
            float* ap = ACCb; LAUNDER(ap);
#pragma unroll
            for (int d0 = 0; d0 < 4; ++d0)
#pragma unroll
                for (int q = 0; q < 4; ++q) { f32x4* a4 = (f32x4*)(ap + nsa_frag_idx(wid, lane, d0, q)); f32x4 v = (f32x4){o[d0][4 * q] * f[4 * q], o[d0][4 * q + 1] * f[4 * q + 1], o[d0][4 * q + 2] * f[4 * q + 2], o[d0][4 * q + 3] * f[4 * q + 3]};
                    if (has_win) v = v + *a4; *a4 = v; }
        }
    }
    __syncthreads();
    {
        const int tk = tid >> 3, j4 = (tid & 7) * 4;
#pragma unroll
        for (int i = 0; i < 4; ++i) { const int j = j4 + i; float v = 0.f;
#pragma unroll
            for (int hd = 0; hd < 4; ++hd) { const float* c2 = CS + (size_t)((hd * 64 + tk) * 32) * 2; v += c2[2 * j]; if (j > 0) v += c2[2 * (j - 1) + 1]; }
            const bool forced = (j == 0) || (j == qb) || (j == qb - 1);
            IMP[tk * 32 + j] = j > qb ? NEG : (forced ? 1000.0f : v); }
    }
    __syncthreads();
    {   const int tk = tid >> 3, j4 = (tid & 7) * 4; unsigned bits = 0u;
#pragma unroll
        for (int i = 0; i < 4; ++i) { const int j = j4 + i; const float vj = IMP[tk * 32 + j]; int cnt = 0;
#pragma unroll 8
            for (int j2 = 0; j2 < 32; ++j2) { const float v2 = IMP[tk * 32 + j2]; cnt += (v2 > vj || (v2 == vj && j2 < j)) ? 1 : 0; }
            if (cnt < 16 && j <= qb) bits |= 1u << j; }
        bits |= SHFLXU(bits, 1); bits |= SHFLXU(bits, 2); bits |= SHFLXU(bits, 4);
        if ((tid & 7) == 0) SELM[tk] = bits;
    }
    __syncthreads();
    if (wid == 0) { unsigned v = SELM[lane];
#pragma unroll
        for (int o_ = 1; o_ < 64; o_ <<= 1) v |= SHFLXU(v, o_);
        if (lane == 0) *UNI = v; }
    __syncthreads();
    const unsigned selm = SELM[tau], uni = *UNI;
#ifdef CPU_EMU
    { extern unsigned g_dbg_selm[64]; extern float g_dbg_imp[64 * 32]; if (tid < 64) g_dbg_selm[tid] = SELM[tid]; for (int i = tid; i < 2048; i += 512) g_dbg_imp[i] = IMP[i]; }
#endif
    {   m_reg = -1e30f; l_reg = 0.f; ZERO_O();
        int jlo, jhi; nsa_range(qb, k, K, jlo, jhi);
        int j = jlo; while (j < jhi && !((uni >> j) & 1u)) ++j;
        int cur = 0;
        __syncthreads();
        if (j < jhi) kv_dma(KVS + (size_t)(tb + 64 * j) * 256, KVS + (size_t)(tb + 64 * j) * 256 + 128, 256, lds, 0, wid, lane);
        DMA_WAIT(); __syncthreads();
#pragma unroll 1
        while (j < jhi) {
            int jn = j + 1; while (jn < jhi && !((uni >> jn) & 1u)) ++jn;
            if (jn < jhi) kv_dma(KVS + (size_t)(tb + 64 * jn) * 256, KVS + (size_t)(tb + 64 * jn) * 256 + 128, 256, lds, cur ^ 1, wid, lane);
            f32x16 p0, p1; qkt<0>(p0, p1, lds + L_K + cur * SHM_K, r32, hi, qr);
            if (!((selm >> j) & 1u)) {
#pragma unroll
                for (int r = 0; r < 16; ++r) { p0[r] = NEG; p1[r] = NEG; } }
            else if (j == qb) {
#pragma unroll
                for (int r = 0; r < 16; ++r) { const int c = crow(r, hi); if (c > tau) p0[r] = NEG; if (c + 32 > tau) p1[r] = NEG; } }
            partialSM(p0, p1, m_reg, alpha); RESC(alpha);
            l_reg = l_reg * alpha + rowsum2(p0, p1);
            packP(p0, p1, pa0, pa1, pa2, pa3); pv_tile<0>(o, vb0 + cur * SHM_V, pa0, pa1, pa2, pa3);
            DMA_WAIT(); __syncthreads(); cur ^= 1;
            j = jn;
        }
        if (K == 1) {
            float f[16]; ROWFAC(gs[1] / l_reg, f);
            __syncthreads();
            float* OT = (float*)lds + (size_t)(32 * wid + 4 * hi) * 128 + r32; const float* ab = ACCb; LAUNDER(ab);
#pragma unroll
            for (int d0 = 0; d0 < 4; ++d0)
#pragma unroll
                for (int q = 0; q < 4; ++q) { const f32x4 v = *(const f32x4*)(ab + nsa_frag_idx(wid, lane, d0, q));
#pragma unroll
                    for (int i = 0; i < 4; ++i) { const int r = 4 * q + i; OT[((r & 3) + 8 * (r >> 2)) * 128 + d0 * 32] = v[i] + o[d0][r] * f[r]; } }
        } else {
        float* sb = SLCb; LAUNDER(sb);
#pragma unroll
        for (int d0 = 0; d0 < 4; ++d0)
#pragma unroll
            for (int q = 0; q < 4; ++q) *(f32x4*)(sb + nsa_frag_idx(wid, lane, d0, q)) = (f32x4){o[d0][4 * q], o[d0][4 * q + 1], o[d0][4 * q + 2], o[d0][4 * q + 3]};
        if (hi == 0) *(f32x2*)((float*)(p.ws + WS_NML) + (size_t)((pid0 + k) * 256 + 32 * wid + r32) * 2) = (f32x2){m_reg, l_reg};
        }
    }
    if (K != 1) {
    if (dry) return;
    unsigned* TICK = (unsigned*)(lds + L_UNI + 16);
#ifndef CPU_EMU
    asm volatile("s_waitcnt vmcnt(0)" ::: "memory");
#endif
    __syncthreads();
    if (tid == 0) *TICK = part_arrive((unsigned*)(p.ws + WS_NCNT) + (size_t)l * BATCH * 32 + b * 32 + qb);
    __syncthreads();
    const unsigned ticket = *TICK;
    if (ticket != (unsigned)(K - 1)) return;
#ifndef CPU_EMU
    if (tid == 0) { __builtin_amdgcn_fence(__ATOMIC_ACQUIRE, "agent"); asm volatile("s_waitcnt vmcnt(0)" ::: "memory"); }
#endif
    __syncthreads();
    {   const float* ML = (const float*)(p.ws + WS_NML) + (size_t)(pid0 * 256 + 32 * wid + r32) * 2;
        float mk[3], lk[3]; float M = -1e30f;
#pragma unroll
        for (int kk = 0; kk < 3; ++kk) { const int kc = kk < K ? kk : 0; const f32x2 v = *(const f32x2*)(ML + (size_t)kc * 512); mk[kk] = kk < K ? v[0] : -1e30f; lk[kk] = kk < K ? v[1] : 0.f; M = fmaxf(M, mk[kk]); }
        float L = 0.f;
#pragma unroll
        for (int kk = 0; kk < 3; ++kk) { mk[kk] = EXP2F((mk[kk] - M) * C2); L += mk[kk] * lk[kk]; }
        const float gl = gs[1] / L;
        ZERO_O();
#pragma unroll 1
        for (int kk = 0; kk < K; ++kk) { const float fk = (kk == 0 ? mk[0] : (kk == 1 ? mk[1] : mk[2])) * gl; float f[16]; ROWFAC(fk, f);
            const float* sb = (const float*)(p.ws + WS_NSLC + (size_t)(pid0 + kk) * NSA_PART_BYTES); LAUNDER(sb);
#pragma unroll
            for (int d0 = 0; d0 < 4; ++d0)
#pragma unroll
                for (int q = 0; q < 4; ++q) { const f32x4 v = *(const f32x4*)(sb + nsa_frag_idx(wid, lane, d0, q));
#pragma unroll
                    for (int i = 0; i < 4; ++i) o[d0][4 * q + i] += v[i] * f[4 * q + i]; } }
#pragma unroll 1
        for (int s2 = 0; s2 < 2; ++s2) { const int kk = s2 == 0 ? 0 : K - 1; if (s2 == 1 && K == 1) break;
            const float* ab = (const float*)(p.ws + WS_NACC + (size_t)(pid0 + kk) * NSA_PART_BYTES); LAUNDER(ab);
#pragma unroll
            for (int d0 = 0; d0 < 4; ++d0)
#pragma unroll
                for (int q = 0; q < 4; ++q) { const f32x4 v = *(const f32x4*)(ab + nsa_frag_idx(wid, lane, d0, q));
#pragma unroll
                    for (int i = 0; i < 4; ++i) o[d0][4 * q + i] += v[i]; } }
        __syncthreads();
        float* OT = (float*)lds + (size_t)(32 * wid + 4 * hi) * 128 + r32;
#pragma unroll
        for (int r = 0; r < 16; ++r)
#pragma unroll
            for (int d0 = 0; d0 < 4; ++d0) OT[((r & 3) + 8 * (r >> 2)) * 128 + d0 * 32] = o[d0][r];
    }
    }
    __syncthreads();
    {   const float* OT = (const float*)lds; const int R0 = 32 * wid, hd = R0 >> 6, tk0 = R0 & 63;
        unsigned zz[4][8]; f32x2 g;
#pragma unroll
        for (int r8 = 0; r8 < 4; ++r8) load_zg<8>(p, l, zz[r8], g, tb + t0 + tk0 + 8 * r8, 1024 + 128 * hd, C_NZ + 128 * hd, lane);
#pragma unroll
        for (int r8 = 0; r8 < 4; ++r8) { f32x2 v[8];
#pragma unroll
            for (int r = 0; r < 8; ++r) v[r] = *(const f32x2*)(OT + (size_t)(R0 + 8 * r8 + r) * 128 + 2 * lane);
            finalize_core<8>(p, v, zz[r8], g, tb + t0 + tk0 + 8 * r8, 1024 + 128 * hd, lane); }
    }
#undef ZERO_O
#undef RESC
#undef ROWFAC
}
constexpr int NU_NSA_A = BATCH * 32, NU_NSA_B = BATCH * (32 - NSA_SPLIT_QB);
DEV void nsa_unit_a(const Params& p, int l, int u, unsigned char* lds) { const int b = u % BATCH, qb = 31 - u / BATCH; const int K = nsa_nparts(qb); nsa_part(p, l, b, qb, K - 1, K, lds); }
DEV void nsa_unit_b(const Params& p, int l, int u, unsigned char* lds) { const int b = u % BATCH, qb = 31 - u / BATCH; nsa_part(p, l, b, qb, 0, 2, lds); }

constexpr int NU_CMP = 2 * BATCH * 9 * 4, NU_CONF = BATCH * 64, NU_LRUA = BATCH * 128, NU_GLAA = BATCH * 128;
constexpr int NU_CONV = (IT_LAYER + 7) / 8;
constexpr int NU_MX = NU_CMP + NU_NSA_A + NU_CONF + NU_NSA_B + NU_LRUA + NU_GLAA + NU_CONV;

DEV void mx_unit(const Params& p, int l, int u, unsigned char* lds) {
    if (u < NU_CMP) { cmp_unit(p, l, u, lds); if (PROBE_U == 1) cmp_unit(p, l, u, lds); return; } u -= NU_CMP;
    if (u < NU_NSA_A) { nsa_unit_a(p, l, u, lds); return; } u -= NU_NSA_A;
    if (u < NU_NSA_B) { nsa_unit_b(p, l, u, lds); return; } u -= NU_NSA_B;
    if (u < NU_CONF) { conf_unit(p, l, u, lds); if (PROBE_U == 3) conf_unit(p, l, u, lds); return; } u -= NU_CONF;
    if (u < NU_LRUA) { lru_a_unit(p, l, u, lds); if (PROBE_U == 4) lru_a_unit(p, l, u, lds); return; } u -= NU_LRUA;
    if (u < NU_GLAA) { gla_a_unit(p, l, u, lds); if (PROBE_U == 5) gla_a_unit(p, l, u, lds); return; } u -= NU_GLAA;
    {
        const int tid = opaque_tid(), lane = tid & 63, wid = UNIFORM(tid >> 6); __syncthreads();
        const int it = u * 8 + wid; if (l + 1 < DEPTH && it < IT_LAYER) p0_item(p, (l + 1) * IT_LAYER + it, (float*)lds + wid * (64 * 65), lane); }
}

#ifndef CPU_EMU
namespace pg8 {
#define PG8_LAS __attribute__((address_space(3)))
constexpr int BM = 256, BK = 64, HALF = 128, HTB = HALF * BK * 2, STAGE_BYTES = 8 * HTB, NXCD = 8, WGM = 8;
__host__ __device__ __forceinline__ int lds_byte(int r, int c) { const int st = (r >> 4) * 2 + (c >> 5), rr = r & 15, cc = c & 31, ob = rr * 64 + cc * 2; return st * 1024 + (ob ^ (((ob >> 9) & 1) << 5)); }
__host__ __device__ __forceinline__ void stage_rc(int b, int& R, int& C) { const int st = b / 1024, sb = b % 1024, swz = sb ^ (((sb >> 9) & 1) << 5); R = (st >> 1) * 16 + swz / 64; C = (st & 1) * 32 + (swz % 64) / 2; }
__host__ __device__ __forceinline__ int perm32(int rho) { const int n = rho >> 4, i = rho & 15; return 8 * (i >> 2) + 4 * n + (i & 3); }
struct Unit { int pm, pn; };
struct Gemm { const bf16_t* A; const bf16_t* Bt; int M, N, K; };
struct StaticOrder {
    int nM, nN, nwg, G, c;
    __host__ __device__ void init(int M, int N, int G_, int c_) { nM = M / BM; nN = N / BM; nwg = nM * nN; G = G_; c = c_; }
    __host__ __device__ bool next(int i, Unit& u) const {
        const long L = (long)i * G + c; if (L >= nwg) return false;
        int wgid = (int)L; { const int q = nwg / NXCD, r = nwg % NXCD, xcd = wgid % NXCD, off = wgid / NXCD; wgid = (xcd < r ? xcd * (q + 1) : r * (q + 1) + (xcd - r) * q) + off; }
        const int nig = WGM * nN, gid = wgid / nig, fm = gid * WGM, gsz = (nM - fm) < WGM ? (nM - fm) : WGM;
        u.pm = fm + ((wgid % nig) % gsz); u.pn = (wgid % nig) / gsz; return true;
    }
    __device__ __forceinline__ void a_ready(const Unit&) const {}
    __device__ __forceinline__ void done(const Unit&) const {}
};
struct EpiBf16 {
    static constexpr bool PERM = true, AFTER_DRAIN = false;
    bf16_t* O; int ldc; bf16_t* O2; int pn2;
    const PG8_LAS float* rsc; int rs_stride;
    __device__ __forceinline__ void operator()(const f32x4 (&acc)[2][2][4][2], const Unit& u, int wr, int wc, int fr, int fq, int ui) const {
        const int row0 = u.pm * BM + wr * 64 + fr; const bool red = (unsigned)(u.pn - pn2) < 3u;
        bf16_t* base = red ? O2 + (size_t)(u.pn - pn2) * T * 256 : O; const int ld = red ? 256 : ldc; const int col0 = (red ? 0 : u.pn * BM) + wc * 32 + 8 * fq;
#pragma unroll
        for (int ai = 0; ai < 2; ++ai)
#pragma unroll
            for (int m = 0; m < 4; ++m) { bf16_t* rowp = base + (size_t)(row0 + ai * HALF + m * 16) * ld + col0; const float sc = rsc[ui * rs_stride + ai * HALF + wr * 64 + m * 16 + fr];
#pragma unroll
                for (int bj = 0; bj < 2; ++bj) { const f32x4 v0 = acc[ai][bj][m][0] * sc, v1 = acc[ai][bj][m][1] * sc;
                    u32x4 w; w.x = cvtpk(v0[0], v0[1]); w.y = cvtpk(v0[2], v0[3]); w.z = cvtpk(v1[0], v1[1]); w.w = cvtpk(v1[2], v1[3]);
                    *(u32x4*)(rowp + bj * HALF) = w; } }
    }
};

struct PanelSS {
    float* xsl; unsigned* cnt;
    __device__ __forceinline__ void run(const f32x4 (&v)[2][2][4][2], const Unit& u, int wr, int wc, int fr, int fq, PG8_LAS unsigned char* lds, int wid, int lane) const {
        PG8_LAS float* P = (PG8_LAS float*)lds;
        PG8_LAS float* S = (PG8_LAS float*)(lds + 8192);
#pragma unroll
        for (int ai = 0; ai < 2; ++ai)
#pragma unroll
            for (int m = 0; m < 4; ++m) { float q = 0.f;
#pragma unroll
                for (int bj = 0; bj < 2; ++bj)
#pragma unroll
                    for (int n = 0; n < 2; ++n) { const f32x4 x = v[ai][bj][m][n]; q += (x[0] * x[0] + x[1] * x[1]) + (x[2] * x[2] + x[3] * x[3]); }
                q += __shfl_xor(q, 16); q += __shfl_xor(q, 32);
                if (fq == 0) P[(ai * HALF + wr * 64 + m * 16 + fr) * 4 + wc] = q; }
        asm volatile("s_waitcnt lgkmcnt(0)" ::: "memory"); __builtin_amdgcn_s_barrier(); asm volatile("" ::: "memory");
        const int row = wid * 32 + (lane & 31);
        if (lane < 32) { const float t = (P[row * 4 + 0] + P[row * 4 + 1]) + (P[row * 4 + 2] + P[row * 4 + 3]);
            __hip_atomic_store((unsigned*)xsl + ((size_t)(u.pm * BM + row) * 8 + u.pn), __builtin_bit_cast(unsigned, t), __ATOMIC_RELAXED, __HIP_MEMORY_SCOPE_AGENT); }
        asm volatile("s_waitcnt vmcnt(0)" ::: "memory");
        if (lane == 0) __hip_atomic_fetch_add(cnt + 64 * u.pm, 1u, __ATOMIC_RELAXED, __HIP_MEMORY_SCOPE_AGENT);
        if (wid == 0) { unsigned sp = 0u;
            while ((unsigned)__builtin_amdgcn_readfirstlane(__hip_atomic_load(cnt + 64 * u.pm, __ATOMIC_RELAXED, __HIP_MEMORY_SCOPE_AGENT)) < 64u && ++sp < (1u << 20)) __builtin_amdgcn_s_sleep(2); }
        asm volatile("s_waitcnt vmcnt(0) lgkmcnt(0)" ::: "memory"); __builtin_amdgcn_s_barrier(); asm volatile("" ::: "memory");
        if (lane < 32) { const unsigned* sl = (const unsigned*)xsl + (size_t)(u.pm * BM + row) * 8; float t = 0.f;
#pragma unroll
            for (int j = 0; j < 8; ++j) t += __builtin_bit_cast(float, __hip_atomic_load(sl + j, __ATOMIC_RELAXED, __HIP_MEMORY_SCOPE_AGENT));
            S[row] = __builtin_amdgcn_rsqf(t * (1.0f / 2048.0f) + 1e-6f); }
        asm volatile("s_waitcnt lgkmcnt(0)" ::: "memory"); __builtin_amdgcn_s_barrier(); asm volatile("" ::: "memory");
    }
    __device__ __forceinline__ void publish(const f32x4 (&v)[2][2][4][2], const Unit& u, int wr, int wc, int fr, int fq, PG8_LAS unsigned char* lds, int wid, int lane) const {
        PG8_LAS float* P = (PG8_LAS float*)lds;
#pragma unroll
        for (int ai = 0; ai < 2; ++ai)
#pragma unroll
            for (int m = 0; m < 4; ++m) { float q = 0.f;
#pragma unroll
                for (int bj = 0; bj < 2; ++bj)
#pragma unroll
                    for (int n = 0; n < 2; ++n) { const f32x4 x = v[ai][bj][m][n]; q += (x[0] * x[0] + x[1] * x[1]) + (x[2] * x[2] + x[3] * x[3]); }
                q += __shfl_xor(q, 16); q += __shfl_xor(q, 32);
                if (fq == 0) P[(ai * HALF + wr * 64 + m * 16 + fr) * 4 + wc] = q; }
        asm volatile("s_waitcnt lgkmcnt(0)" ::: "memory"); __builtin_amdgcn_s_barrier(); asm volatile("" ::: "memory");
        const int row = wid * 32 + (lane & 31);
        if (lane < 32) { const float t = (P[row * 4 + 0] + P[row * 4 + 1]) + (P[row * 4 + 2] + P[row * 4 + 3]);
            __hip_atomic_store((unsigned*)xsl + ((size_t)(u.pm * BM + row) * 8 + u.pn), __builtin_bit_cast(unsigned, t), __ATOMIC_RELAXED, __HIP_MEMORY_SCOPE_AGENT); }
    }
};
struct EpiRow {
    static constexpr bool PERM = false, AFTER_DRAIN = true;
    const float* xin_f32; const bf16_t* xin_bf; float* xout_f32; bf16_t* xout_bf; bf16_t* H; const float* post_g; const float* pre_g; PanelSS st1, st2;
    __device__ __forceinline__ void fused(f32x4 (&acc)[2][2][4][2], const Unit& u, int wr, int wc, int fr, int fq, PG8_LAS unsigned char* lds, int wid, int lane) const {
        const PG8_LAS float* S = (const PG8_LAS float*)(lds + 8192);
        const int col0 = u.pn * BM + wc * 32 + 4 * fq;
        u32x2 xw[2][4][2][2];
        {
#pragma unroll
            for (int ai = 0; ai < 2; ++ai)
#pragma unroll
                for (int m = 0; m < 4; ++m) { const size_t off = (size_t)(u.pm * BM + ai * HALF + wr * 64 + m * 16 + fr) * DM + col0;
#pragma unroll
                    for (int bj = 0; bj < 2; ++bj)
#pragma unroll
                        for (int n = 0; n < 2; ++n) xw[ai][m][bj][n] = *(const u32x2*)(xin_bf + off + bj * HALF + n * 16); } }
        f32x4 pg[2][2];
#pragma unroll
        for (int bj = 0; bj < 2; ++bj)
#pragma unroll
            for (int n = 0; n < 2; ++n) pg[bj][n] = *(const f32x4*)(post_g + col0 + bj * HALF + n * 16);
        st1.run(acc, u, wr, wc, fr, fq, lds, wid, lane);
#pragma unroll
        for (int ai = 0; ai < 2; ++ai)
#pragma unroll
            for (int m = 0; m < 4; ++m) { const int r = ai * HALF + wr * 64 + m * 16 + fr; const float rs = S[r]; const size_t off = (size_t)(u.pm * BM + r) * DM + col0;
#pragma unroll
                for (int bj = 0; bj < 2; ++bj)
#pragma unroll
                    for (int n = 0; n < 2; ++n) { f32x4 xo;
                        { const u32x2 w = xw[ai][m][bj][n]; xo = (f32x4){__builtin_bit_cast(float, w.x << 16), __builtin_bit_cast(float, w.x & 0xffff0000u), __builtin_bit_cast(float, w.y << 16), __builtin_bit_cast(float, w.y & 0xffff0000u)}; }
                        const f32x4 xn = xo + acc[ai][bj][m][n] * rs * pg[bj][n]; acc[ai][bj][m][n] = xn;
                        if (xout_f32) *(f32x4*)(xout_f32 + off + bj * HALF + n * 16) = xn;
                        else *(u32x2*)(xout_bf + off + bj * HALF + n * 16) = (u32x2){cvtpk(xn[0], xn[1]), cvtpk(xn[2], xn[3])}; }
                asm volatile("" : "+v"(acc[ai][0][m][0]), "+v"(acc[ai][0][m][1]), "+v"(acc[ai][1][m][0]), "+v"(acc[ai][1][m][1]));
                if (m & 1) asm volatile("" ::: "memory"); }
        if (!H) return;
        st2.publish(acc, u, wr, wc, fr, fq, lds, wid, lane);
    }
};
template <class Epi, class Sched, bool ALIGN_EPI = false, bool SP2 = false>
__device__ __forceinline__ void gemm_phase(PG8_LAS unsigned char* lds, const Gemm g, const Sched& S, const Epi& E) {
    const int tid = opaque_tid(), wid = __builtin_amdgcn_readfirstlane(tid >> 6), lane = tid & 63, wr = wid >> 2, wc = wid & 3, fr = lane & 15, fq = lane >> 4;
    const int K = g.K, nt = K / BK;
    unsigned voffA[2], voffB[2];
#pragma unroll
    for (int i = 0; i < 2; ++i) { int R, C; stage_rc(tid * 16 + i * 8192, R, C); const int Rb = Epi::PERM ? ((R & ~31) + perm32(R & 31)) : R;
        voffA[i] = (unsigned)(R * K + C) * 2u; voffB[i] = (unsigned)(Rb * K + C) * 2u; }
    const size_t kstep = (size_t)(BK * 2);
    const size_t hstep = (size_t)HALF * K * 2;
    const size_t tstep = 2 * hstep;
    const unsigned ldsw = (unsigned)wid * 1024u;
    const int aoff = lds_byte(wr * 64 + fr, fq * 8), boff = lds_byte(wc * 32 + fr, fq * 8);
#define PG8_SA(b, h) (((b) * 2 + (h)) * HTB)
#define PG8_SB(b, h) ((4 + (b) * 2 + (h)) * HTB)
#define PG8_STAGE(bufoff, gbase, voff) do { _Pragma("unroll") for (int _i = 0; _i < 2; ++_i) \
        __builtin_amdgcn_global_load_lds((const unsigned*)((const char*)(gbase) + (voff)[_i]), (PG8_LAS unsigned*)(lds + (bufoff) + ldsw + _i * 8192), 16, 0, 0); } while (0)
#define PG8_LDA(dst, b, h) do { _Pragma("unroll") for (int m = 0; m < 4; ++m) _Pragma("unroll") for (int k = 0; k < 2; ++k) dst[m][k] = *(const PG8_LAS bf16x8*)(lds + PG8_SA(b, h) + aoff + m * 2048 + k * 1024); } while (0)
#define PG8_LDB(dst, b, h) do { _Pragma("unroll") for (int n = 0; n < 2; ++n) _Pragma("unroll") for (int k = 0; k < 2; ++k) dst[n][k] = *(const PG8_LAS bf16x8*)(lds + PG8_SB(b, h) + boff + n * 2048 + k * 1024); } while (0)
#define PG8_MMA(ai, bj, At, Bt) do { __builtin_amdgcn_s_setprio(1); _Pragma("unroll") for (int m = 0; m < 4; ++m) _Pragma("unroll") for (int n = 0; n < 2; ++n) _Pragma("unroll") for (int k = 0; k < 2; ++k) \
        acc[ai][bj][m][n] = __builtin_amdgcn_mfma_f32_16x16x32_bf16(Bt[n][k], At[m][k], acc[ai][bj][m][n], 0, 0, 0); __builtin_amdgcn_s_setprio(0); } while (0)
#define PG8_WAIT_V(n) asm volatile("s_waitcnt vmcnt(" #n ")" ::: "memory")
#define PG8_WAIT_L(n) asm volatile("s_waitcnt lgkmcnt(" #n ")" ::: "memory")
#define PG8_BAR __builtin_amdgcn_s_barrier()
#define PG8_SCHED __builtin_amdgcn_sched_barrier(0)
    Unit cur, nxt; int ui = 0;
    if (!S.next(0, cur)) return;
    f32x4 acc[2][2][4][2];
#pragma unroll
    for (int a = 0; a < 2; ++a)
#pragma unroll
        for (int b = 0; b < 2; ++b)
#pragma unroll
            for (int m = 0; m < 4; ++m)
#pragma unroll
                for (int n = 0; n < 2; ++n) acc[a][b][m][n] = (f32x4){0.f, 0.f, 0.f, 0.f};
    bf16x8 At[4][2], B0[2][2], B1[2][2];
    const char* cA = (const char*)g.A + (size_t)cur.pm * tstep; const char* cB = (const char*)g.Bt + (size_t)cur.pn * tstep;
    S.a_ready(cur);
    if constexpr (SP2) {
        PG8_STAGE(PG8_SB(0, 0), cB, voffB); PG8_STAGE(PG8_SB(0, 1), cB + hstep, voffB); PG8_STAGE(PG8_SA(0, 0), cA, voffA); PG8_STAGE(PG8_SA(0, 1), cA + hstep, voffA);
        if (wr == 1) PG8_BAR;
        PG8_WAIT_V(2); PG8_BAR;
        PG8_STAGE(PG8_SB(1, 0), cB + kstep, voffB); PG8_STAGE(PG8_SA(1, 0), cA + kstep, voffA); PG8_STAGE(PG8_SB(1, 1), cB + hstep + kstep, voffB);
        PG8_WAIT_V(6); PG8_BAR;
    } else {
        PG8_STAGE(PG8_SB(0, 0), cB, voffB); PG8_STAGE(PG8_SA(0, 0), cA, voffA); PG8_STAGE(PG8_SB(0, 1), cB + hstep, voffB); PG8_STAGE(PG8_SA(0, 1), cA + hstep, voffA);
        if (wr == 1) PG8_BAR;
        PG8_WAIT_V(4); PG8_BAR;
        PG8_STAGE(PG8_SB(1, 0), cB + kstep, voffB); PG8_STAGE(PG8_SA(1, 0), cA + kstep, voffA); PG8_STAGE(PG8_SB(1, 1), cB + hstep + kstep, voffB);
        PG8_WAIT_V(6); PG8_BAR;
    }
    for (;;) {
        const bool has_next = S.next(ui + 1, nxt);
        const char* nA = has_next ? (const char*)g.A + (size_t)nxt.pm * tstep : cA; const char* nB = has_next ? (const char*)g.Bt + (size_t)nxt.pn * tstep : cB;
        for (int t = 0; t < nt; t += 2) {
            const bool last = (t == nt - 2);
            const char* a1 = cA + (size_t)(t + 1) * kstep;
            const char* a2 = last ? nA : cA + (size_t)(t + 2) * kstep; const char* b2 = last ? nB : cB + (size_t)(t + 2) * kstep;
            const char* a3 = a2 + kstep; const char* b3 = b2 + kstep;
            if (last && has_next) S.a_ready(nxt);
            if constexpr (SP2) {
            PG8_LDB(B0, 0, 0); PG8_LDB(B1, 0, 1); PG8_SCHED; PG8_LDA(At, 0, 0); PG8_STAGE(PG8_SA(1, 1), a1 + hstep, voffA);
            PG8_WAIT_V(8); PG8_WAIT_L(0); PG8_BAR; PG8_MMA(0, 0, At, B0); PG8_MMA(0, 1, At, B1); PG8_BAR; PG8_SCHED;
            PG8_LDA(At, 0, 1); PG8_STAGE(PG8_SB(0, 0), b2, voffB); PG8_STAGE(PG8_SB(0, 1), b2 + hstep, voffB); PG8_STAGE(PG8_SA(0, 0), a2, voffA);
            PG8_WAIT_V(8); PG8_WAIT_L(0); PG8_BAR; PG8_MMA(1, 0, At, B0); PG8_MMA(1, 1, At, B1); PG8_BAR; PG8_SCHED;
            PG8_LDB(B0, 1, 0); PG8_LDB(B1, 1, 1); PG8_SCHED; PG8_LDA(At, 1, 0); PG8_STAGE(PG8_SA(0, 1), a2 + hstep, voffA);
            PG8_WAIT_V(8); PG8_WAIT_L(0); PG8_BAR; PG8_MMA(0, 0, At, B0); PG8_MMA(0, 1, At, B1); PG8_BAR; PG8_SCHED;
            PG8_LDA(At, 1, 1); PG8_STAGE(PG8_SB(1, 0), b3, voffB); PG8_STAGE(PG8_SB(1, 1), b3 + hstep, voffB); PG8_STAGE(PG8_SA(1, 0), a3, voffA);
            PG8_WAIT_V(8); PG8_WAIT_L(0); PG8_BAR; PG8_MMA(1, 0, At, B0); PG8_MMA(1, 1, At, B1); PG8_BAR; PG8_SCHED;
            } else {
            PG8_LDB(B0, 0, 0); PG8_SCHED; PG8_LDA(At, 0, 0); PG8_STAGE(PG8_SA(1, 1), a1 + hstep, voffA);
            PG8_WAIT_L(8); PG8_BAR; PG8_WAIT_L(0); PG8_MMA(0, 0, At, B0); PG8_BAR; PG8_SCHED;
            PG8_LDB(B1, 0, 1); PG8_STAGE(PG8_SB(0, 0), b2, voffB);
            PG8_BAR; PG8_WAIT_L(0); PG8_MMA(0, 1, At, B1); PG8_BAR;
            PG8_LDA(At, 0, 1); PG8_STAGE(PG8_SA(0, 0), a2, voffA);
            PG8_BAR; PG8_WAIT_L(0); PG8_MMA(1, 0, At, B0); PG8_BAR; PG8_SCHED;
            PG8_STAGE(PG8_SB(0, 1), b2 + hstep, voffB);
            PG8_WAIT_V(6); PG8_BAR; PG8_MMA(1, 1, At, B1); PG8_BAR;
            PG8_LDB(B0, 1, 0); PG8_SCHED; PG8_LDA(At, 1, 0); PG8_STAGE(PG8_SA(0, 1), a2 + hstep, voffA);
            PG8_WAIT_L(8); PG8_BAR; PG8_WAIT_L(0); PG8_MMA(0, 0, At, B0); PG8_BAR; PG8_SCHED;
            PG8_LDB(B1, 1, 1); PG8_STAGE(PG8_SB(1, 0), b3, voffB);
            PG8_BAR; PG8_WAIT_L(0); PG8_MMA(0, 1, At, B1); PG8_BAR;
            PG8_LDA(At, 1, 1); PG8_STAGE(PG8_SA(1, 0), a3, voffA);
            PG8_BAR; PG8_WAIT_L(0); PG8_MMA(1, 0, At, B0); PG8_BAR; PG8_SCHED;
            PG8_STAGE(PG8_SB(1, 1), b3 + hstep, voffB);
            PG8_WAIT_V(6); PG8_BAR; PG8_MMA(1, 1, At, B1); PG8_BAR;
            }
        }
        if constexpr (ALIGN_EPI) { if (wr == 0) PG8_BAR; }
        if constexpr (!Epi::AFTER_DRAIN) { E(acc, cur, wr, wc, fr, fq, ui); S.done(cur); }
        if (!has_next) break;
#pragma unroll
        for (int a = 0; a < 2; ++a)
#pragma unroll
            for (int b = 0; b < 2; ++b)
#pragma unroll
                for (int m = 0; m < 4; ++m)
#pragma unroll
                    for (int n = 0; n < 2; ++n) acc[a][b][m][n] = (f32x4){0.f, 0.f, 0.f, 0.f};
        cur = nxt; cA = nA; cB = nB; ++ui;
        if constexpr (ALIGN_EPI) { if (wr == 1) PG8_BAR; }
    }
    PG8_WAIT_V(0);
    if constexpr (!ALIGN_EPI) { if (wr == 0) PG8_BAR; }
    PG8_BAR;
    if constexpr (Epi::AFTER_DRAIN) { E.fused(acc, cur, wr, wc, fr, fq, lds, wid, lane); S.done(cur); }
#undef PG8_SA
#undef PG8_SB
#undef PG8_STAGE
#undef PG8_LDA
#undef PG8_LDB
#undef PG8_MMA
#undef PG8_WAIT_V
#undef PG8_WAIT_L
#undef PG8_BAR
#undef PG8_SCHED
}
}


#define LAS __attribute__((address_space(3)))
#define XB_TMO      128
#define XB_XCNT(j)  (256  + 64 * (j))
#define XB_XSUB(j)  (1280 + 64 * (j))
#define XB_XGEN(j)  (2304 + 64 * (j))
#define XB_TOP      3328
#define XB_TOPGEN   3392
#define XCD_BAR_WORDS 3456
#define XB_SPIN_CAP (1u << 18)
__device__ __forceinline__ unsigned xb_ld(unsigned* p)              { return __hip_atomic_load(p, __ATOMIC_RELAXED, __HIP_MEMORY_SCOPE_AGENT); }
__device__ __forceinline__ unsigned xb_add(unsigned* p, unsigned v) { return __hip_atomic_fetch_add(p, v, __ATOMIC_RELAXED, __HIP_MEMORY_SCOPE_AGENT); }
__device__ __forceinline__ unsigned xb_xcc_id() { return (unsigned)__builtin_amdgcn_s_getreg((3 << 11) | 20) & 0xFu; }
#define XB_SPIN(cond, bar) do { unsigned _sp = 0; while (cond) { __builtin_amdgcn_s_sleep(1); \
    if ((++_sp & 255u) == 0u) { if (xb_ld(&(bar)[XB_TMO])) break; if (_sp > XB_SPIN_CAP) { atomicAdd(&(bar)[XB_TMO], 1u); break; } } } } while (0)
struct XcdBarrier { unsigned* bar; unsigned x; volatile LAS unsigned* st; };
__device__ __forceinline__ XcdBarrier xcd_barrier_post(unsigned* bar, volatile LAS unsigned* st) {
    XcdBarrier b; b.bar = bar; b.x = xb_xcc_id(); b.st = st;
    if (threadIdx.x == 0) (void)xb_add(&bar[XB_XCNT(b.x)], 1u);
    return b;
}
__device__ __forceinline__ void xcd_barrier_complete(unsigned* bar, unsigned x, unsigned& nloc, unsigned& nx) {
    const unsigned G = gridDim.x * gridDim.y * gridDim.z;
    unsigned sum, cnt, mine, sp = 0u;
    for (;;) {
        sum = 0u; cnt = 0u; mine = 0u;
#pragma unroll
        for (unsigned j = 0; j < 16; ++j) { const unsigned c = xb_ld(&bar[XB_XCNT(j)]); sum += c; cnt += (c > 0u) ? 1u : 0u; mine = (j == x) ? c : mine; }
        if (sum == G) break;
        __builtin_amdgcn_s_sleep(1);
        if ((++sp & 255u) == 0u) { if (xb_ld(&bar[XB_TMO])) break; if (sp > XB_SPIN_CAP) { atomicAdd(&bar[XB_TMO], 1u); break; } }
    }
    nloc = mine > 0u ? mine : 1u; nx = cnt > 0u ? cnt : 1u;
}
__device__ __forceinline__ void xcd_barrier(const XcdBarrier& b) {
    asm volatile("s_waitcnt vmcnt(0)" ::: "memory");
    __syncthreads();
    if (threadIdx.x == 0) {
        unsigned* bar = b.bar;
        __builtin_amdgcn_s_waitcnt(0);
        unsigned nloc = b.st[0], nx = b.st[1];
        if (nloc == 0u) { xcd_barrier_complete(bar, b.x, nloc, nx); b.st[0] = nloc; b.st[1] = nx; }
        const unsigned old = xb_add(&bar[XB_XSUB(b.x)], 1u);
        const unsigned gen = old / nloc;
        if (old + 1u == (gen + 1u) * nloc) {
            __builtin_amdgcn_fence(__ATOMIC_RELEASE, "agent");
            asm volatile("s_waitcnt vmcnt(0)" ::: "memory");
            const unsigned og = xb_add(&bar[XB_TOP], 1u);
            const unsigned tg = og / nx;
            if (og + 1u == (tg + 1u) * nx) xb_add(&bar[XB_TOPGEN], 1u);
            else XB_SPIN(xb_ld(&bar[XB_TOPGEN]) == tg, bar);
            __builtin_amdgcn_fence(__ATOMIC_ACQUIRE, "agent");
            xb_add(&bar[XB_XGEN(b.x)], 1u);
            asm volatile("s_waitcnt vmcnt(0)" ::: "memory");
        } else {
            XB_SPIN(xb_ld(&bar[XB_XGEN(b.x)]) == gen, bar);
            __builtin_amdgcn_fence(__ATOMIC_ACQUIRE, "agent");
            asm volatile("s_waitcnt vmcnt(0)" ::: "memory");
        }
    }
    __syncthreads();
}
constexpr int LDS_DYN = LDS_BYTES - 32;
constexpr size_t WS_CNT = 32768;
#define DYN_LOOP(which, NU, FN) do { unsigned* ctr_ = (unsigned*)(p.ws + WS_CNT) + (size_t)ph * 64; volatile LAS unsigned* slot_ = (volatile LAS unsigned*)((LAS unsigned char*)lds + LDS_DYN); \
        unsigned nxt_ = 0u; if (threadIdx.x == 0) *slot_ = __hip_atomic_fetch_add(ctr_, 1u, __ATOMIC_RELAXED, __HIP_MEMORY_SCOPE_AGENT); __syncthreads(); \
        int u_ = __builtin_amdgcn_readfirstlane((int)*slot_); \
        while (u_ < (NU)) { if (threadIdx.x == 0) nxt_ = __hip_atomic_fetch_add(ctr_, 1u, __ATOMIC_RELAXED, __HIP_MEMORY_SCOPE_AGENT); \
            FN(p, l, u_, lds); __syncthreads(); if (threadIdx.x == 0) *slot_ = nxt_; __syncthreads(); u_ = __builtin_amdgcn_readfirstlane((int)*slot_); } } while (0)
constexpr int LDS_BAR_ST = LDS_BYTES - 16;
constexpr size_t WS_BAR = 4096;

namespace cg = cooperative_groups;
constexpr int NKIND = 6;
constexpr int PH_PER_LAYER = NKIND + ((PROBE_K && PROBE_K <= NKIND) ? 1 : 0), N_PHASES = 1 + (PROBE_K == 8 ? 1 : 0) + PH_PER_LAYER * DEPTH;
__global__ void __launch_bounds__(NTHR, 2) hybrid_fwd(Params p) {
    extern __shared__ __attribute__((aligned(16))) unsigned char lds[];
    const int G = gridDim.x, bx = blockIdx.x;
    volatile LAS unsigned* bst = (volatile LAS unsigned*)((LAS unsigned char*)lds + LDS_BAR_ST);
    if (threadIdx.x == 0) { bst[0] = 0u; bst[1] = 0u; }
    __syncthreads();
    XcdBarrier xb; xb.bar = (unsigned*)(p.ws + WS_BAR); xb.x = 0u; xb.st = bst;
    const bool fused_rp = (G == 256) && (T == 8192);
    if (bx == 0) { const int tid = threadIdx.x; unsigned* bw = (unsigned*)(p.ws + WS_BAR); for (int i = tid; i < XCD_BAR_WORDS; i += NTHR) __hip_atomic_store(bw + i, 0u, __ATOMIC_RELAXED, __HIP_MEMORY_SCOPE_AGENT);
                   unsigned* cw = (unsigned*)(p.ws + WS_CNT); for (int i = tid; i < 40 * 64; i += NTHR) __hip_atomic_store(cw + i, 0u, __ATOMIC_RELAXED, __HIP_MEMORY_SCOPE_AGENT);
                   unsigned* fw = (unsigned*)(p.ws + WS_FLG); for (int i = tid; i < DEPTH * BATCH * 64; i += NTHR) __hip_atomic_store(fw + i, 0u, __ATOMIC_RELAXED, __HIP_MEMORY_SCOPE_AGENT);
                   unsigned* xw = (unsigned*)(p.ws + WS_XCNT); for (int i = tid; i < DEPTH * 2 * 32; i += NTHR) __hip_atomic_store(xw + (size_t)i * 64, 0u, __ATOMIC_RELAXED, __HIP_MEMORY_SCOPE_AGENT);
                   unsigned* cc = (unsigned*)(p.ws + WS_CCNT); for (int i = tid; i < DEPTH * 2 * BATCH * 9; i += NTHR) __hip_atomic_store(cc + i, 0u, __ATOMIC_RELAXED, __HIP_MEMORY_SCOPE_AGENT);
                   unsigned* nw = (unsigned*)(p.ws + WS_NCNT); for (int i = tid; i < DEPTH * BATCH * 32; i += NTHR) __hip_atomic_store(nw + i, 0u, __ATOMIC_RELAXED, __HIP_MEMORY_SCOPE_AGENT); }
    cg::this_grid().sync(); xb = xcd_barrier_post((unsigned*)(p.ws + WS_BAR), bst);
    for (int ph = p.ph_lo; ph < p.ph_hi; ++ph) {
        const int tid = opaque_tid(), lane = tid & 63, wave = UNIFORM(tid >> 6);
        if (ph == 0 || (PROBE_K == 8 && ph == 1)) {
            float* scr = (float*)lds + wave * (64 * 65);
            const int gw = bx * 8 + wave, NGW = G * 8;
            p0_copy_params(p, bx * NTHR + tid, G * NTHR);
            for (int it = gw; it < IT_LAYER; it += NGW) p0_item(p, it, scr, lane);
            for (int m = gw; m < T; m += NGW) rowpass_row(p, 0, m, lane, fused_rp);
        } else {
            const int ph1 = ph - 1 - (PROBE_K == 8 ? 1 : 0); const int l = ph1 / PH_PER_LAYER; int k = ph1 % PH_PER_LAYER;
            if (PROBE_K && PROBE_K <= NKIND && k >= PROBE_K) --k;
            if (k == 0) {
                const bool xdirect = fused_rp;
                PG8_LAS float* rsc = (PG8_LAS float*)((PG8_LAS unsigned char*)lds + 131072);
                pg8::StaticOrder S; S.init(T, NP, G, bx);
                if (xdirect) { const float* sl = (const float*)(p.ws + WS_XSL) + (size_t)(l >= 1 ? (l - 1) * 2 + 1 : DEPTH * 2) * T * 8;
#pragma unroll
                    for (int i = 0; i < 3; ++i) { pg8::Unit uu; if (S.next(i, uu) && tid < 256) { const f32x4* q = (const f32x4*)(sl + (size_t)(uu.pm * 256 + tid) * 8); const f32x4 a = q[0], b = q[1];
                        rsc[i * 256 + tid] = __builtin_amdgcn_rsqf((((a[0] + a[1]) + (a[2] + a[3])) + ((b[0] + b[1]) + (b[2] + b[3]))) * (1.0f / 2048.0f) + 1e-6f); } }
                } else if (tid < 256) rsc[tid] = 1.0f;
                __syncthreads();
                pg8::Gemm g{(xdirect && l >= 1) ? (const bf16_t*)(p.ws + ((l & 1) ? WS_XA : WS_XB)) : (const bf16_t*)(p.ws + WS_H), (const bf16_t*)(p.ws + WS_WIN) + (size_t)l * NP * DM, T, NP, DM};
                pg8::EpiBf16 E{(bf16_t*)(p.ws + WS_PROJ), NP, (bf16_t*)(p.ws + WS_KVC), C_KC / 256, rsc, xdirect ? 256 : 0};
                pg8::gemm_phase<pg8::EpiBf16, pg8::StaticOrder, true, true>((PG8_LAS unsigned char*)lds, g, S, E);
            } else if (k == 1) {
                DYN_LOOP(0, NU_MX, mx_unit);
            } else if (k == 2) {
                gla_scan(p, bx * NTHR + tid, G * NTHR); lru_scan(p, (G - 1 - bx) * NTHR + tid, G * NTHR);
            } else if (k == 3) {
                const int gw = bx * 8 + wave, NGW = G * 8; float* tile = (float*)lds + wave * 2048;
                for (int wu = gw; wu < NW_GLAC; wu += NGW) gla_c_wave(p, l, wu, lane, tile);
                for (int wu = gw; wu < NW_LRUB; wu += NGW) lru_b_wave(p, l, wu, lane);
            } else if (k == 4) {
                pg8::Gemm g{(const bf16_t*)(p.ws + WS_MIXED), (const bf16_t*)(p.ws + WS_WOUT) + (size_t)l * DM * DM, T, DM, DM};
                pg8::StaticOrder S; S.init(T, DM, G, bx);
                if (fused_rp) {
                    const int l1 = l + 1; const bool last = (l1 == DEPTH);
                    float* xs = (float*)(p.ws + WS_XSL) + (size_t)(l * 2) * T * 8; unsigned* xc = (unsigned*)(p.ws + WS_XCNT) + (size_t)(l * 2) * 32 * 64;
                    pg8::EpiRow E{nullptr, l1 <= 1 ? (const bf16_t*)(p.ws + WS_H) : (const bf16_t*)(p.ws + ((l1 & 1) ? WS_XB : WS_XA)), last ? p.out : nullptr, last ? nullptr : (bf16_t*)(p.ws + ((l1 & 1) ? WS_XA : WS_XB)),
                                  last ? nullptr : (bf16_t*)(p.ws + WS_H), PARF(p, PO_POST_G) + (size_t)l * DM, last ? nullptr : PARF(p, PO_PRE_G) + (size_t)l1 * DM,
                                  pg8::PanelSS{xs, xc}, pg8::PanelSS{xs + (size_t)T * 8, xc + 32 * 64}};
                    pg8::gemm_phase<pg8::EpiRow, pg8::StaticOrder, false, true>((PG8_LAS unsigned char*)lds, g, S, E);
                } else { PG8_LAS float* rsc = (PG8_LAS float*)((PG8_LAS unsigned char*)lds + 131072); if (tid < 256) rsc[tid] = 1.0f; __syncthreads();
                    pg8::EpiBf16 E{(bf16_t*)(p.ws + WS_Y), DM, (bf16_t*)(p.ws + WS_Y), 4096, rsc, 0};
                    pg8::gemm_phase<pg8::EpiBf16, pg8::StaticOrder, true, true>((PG8_LAS unsigned char*)lds, g, S, E); }
            } else if (!fused_rp) {
                const int gw = bx * 8 + wave, NGW = G * 8;
                for (int m = gw; m < T; m += NGW) rowpass_row(p, l + 1, m, lane);
            }
        }
        if (fused_rp && ph > 0 && ((ph - 1 - (PROBE_K == 8 ? 1 : 0)) % PH_PER_LAYER) == PH_PER_LAYER - 1) continue;
        if (ph + 1 < p.ph_hi) {
            xcd_barrier(xb);
        }
    }
}

#ifndef N_LAUNCH_MODE
#define N_LAUNCH_MODE 0
#endif
extern "C" void kernel_launch(void* const* d_in, const int* in_sizes, int n_in, void* d_out, int out_size, void* d_ws, size_t ws_size, hipStream_t stream) {
    static int grid = 0;
    if (grid == 0) {
        if (n_in != N_IN || out_size != T * DM || ws_size < WS_END) { fprintf(stderr, "kernel_launch: unexpected shapes (n_in %d out %d ws %zu need %zu)\n", n_in, out_size, ws_size, (size_t)WS_END); grid = -1; return; }
        int dev = 0, cus = 0, per_cu = 0;
        (void)hipGetDevice(&dev); (void)hipDeviceGetAttribute(&cus, hipDeviceAttributeMultiprocessorCount, dev);
        if (hipFuncSetAttribute((const void*)hybrid_fwd, hipFuncAttributeMaxDynamicSharedMemorySize, LDS_BYTES) != hipSuccess) { fprintf(stderr, "kernel_launch: hipFuncSetAttribute failed\n"); grid = -1; return; }
        if (hipOccupancyMaxActiveBlocksPerMultiprocessor(&per_cu, (const void*)hybrid_fwd, NTHR, LDS_BYTES) != hipSuccess || per_cu < 1) { fprintf(stderr, "kernel_launch: occupancy query says %d\n", per_cu); per_cu = 1; }
        (void)hipGetLastError();
        grid = cus * 1;
        if (grid <= 0) grid = 256;
    }
    if (grid < 0) return;
    Params p{};
    for (int i = 0; i < N_IN; ++i) p.in[i] = (const float*)d_in[i];
    p.out = (float*)d_out; p.ws = (unsigned char*)d_ws;
#if N_LAUNCH_MODE == 0
    p.ph_lo = 0; p.ph_hi = N_PHASES;
    { void* args[] = {&p}; hipError_t e = hipLaunchCooperativeKernel((const void*)hybrid_fwd, dim3(grid), dim3(NTHR), args, LDS_BYTES, stream);
      if (e != hipSuccess) fprintf(stderr, "cooperative launch failed: %s (grid %d)\n", hipGetErrorString(e), grid); }
#else
    for (int ph = 0; ph < N_PHASES; ++ph) { p.ph_lo = ph; p.ph_hi = ph + 1; void* args[] = {&p};
        hipError_t e = hipLaunchCooperativeKernel((const void*)hybrid_fwd, dim3(grid), dim3(NTHR), args, LDS_BYTES, stream);
        if (e != hipSuccess) { fprintf(stderr, "launch %d failed: %s\n", ph, hipGetErrorString(e)); break; } }
#endif
}
#endif
```
